# Optimizing an MI355X kernel written in HIP

```python
import math
import jax, jax.numpy as jnp
from jax import lax
import numpy as np

D_MODEL = 2048
BATCH = 1
SEQ = 8192
DEPTH = 1

MEM_LEN = 256
MEM_HEADS = 4
MEM_HEAD_DIM = D_MODEL // MEM_HEADS

BLOCK_Q = 128

SB_HEADS = 8
SB_HEAD_DIM = D_MODEL // 16
SB_WIDTH = SB_HEADS * SB_HEAD_DIM

DIFF_HEADS = 8
DIFF_V_DIM = D_MODEL // 16
DIFF_QK_DIM = DIFF_V_DIM // 2
DIFF_Q_WIDTH = DIFF_HEADS * 2 * DIFF_QK_DIM
DIFF_WIDTH = DIFF_HEADS * DIFF_V_DIM

MIX_WIDTH = SB_WIDTH + DIFF_WIDTH
IN_SPLITS = (SB_WIDTH, SB_WIDTH, SB_WIDTH, DIFF_Q_WIDTH, DIFF_Q_WIDTH, DIFF_WIDTH)
IN_WIDTH = sum(IN_SPLITS)

ROPE_DIM = DIFF_QK_DIM // 4
ROPE_THETA = 500000.0

PEER_HEADS = 8
N_KEYS = 128
N_EXPERTS = N_KEYS * N_KEYS
PEER_TOPK = 16
PEER_QUERY_DIM = 256
PEER_HALF = PEER_QUERY_DIM // 2
PEER_TOKEN_BLOCK = 128

LN_EPS = 1e-5
RMS_EPS = 1e-6
DEEPNORM_ALPHA = (2 * DEPTH) ** 0.25
DEEPNORM_BETA = (8 * DEPTH) ** -0.25

kernel_name = "hybrid_stickbreak_diffattn_peer_deepnorm"


def layer_norm(x, g, b):
    xf = x.astype(jnp.float32)
    mu = jnp.mean(xf, axis=-1, keepdims=True)
    var = jnp.mean(jnp.square(xf - mu), axis=-1, keepdims=True)
    return ((xf - mu) * lax.rsqrt(var + LN_EPS) * g.astype(jnp.float32)
            + b.astype(jnp.float32)).astype(x.dtype)


def rms_norm(x, g):
    xf = x.astype(jnp.float32)
    xf = xf * lax.rsqrt(jnp.mean(jnp.square(xf), axis=-1, keepdims=True) + RMS_EPS)
    return (xf * g.astype(jnp.float32)).astype(x.dtype)


def rope_partial(t, positions):
    half = ROPE_DIM // 2
    inv_freq = jnp.power(ROPE_THETA, -jnp.arange(half, dtype=jnp.float32) * 2.0 / ROPE_DIM)
    ang = positions.astype(jnp.float32)[:, None] * inv_freq[None, :]
    cos = jnp.cos(ang).astype(t.dtype)
    sin = jnp.sin(ang).astype(t.dtype)
    t1 = t[..., :half]
    t2 = t[..., half:ROPE_DIM]
    rest = t[..., ROPE_DIM:]
    return jnp.concatenate([t1 * cos - t2 * sin, t2 * cos + t1 * sin, rest], axis=-1)


def to_query_blocks(t):
    b, h, s, d = t.shape
    return t.reshape(b, h, s // BLOCK_Q, BLOCK_Q, d).transpose(2, 0, 1, 3, 4)


def from_query_blocks(o):
    nb, b, h, q, d = o.shape
    return o.transpose(1, 0, 3, 2, 4).reshape(b, nb * q, h, d)


def stick_breaking_attention(q, k, v):
    s_len, d = q.shape[2], q.shape[3]
    scale = 1.0 / math.sqrt(d)
    key_pos = jnp.arange(s_len)
    starts = jnp.arange(s_len // BLOCK_Q) * BLOCK_Q

    def block(args):
        qb, start = args
        z = jnp.einsum('bhqd,bhkd->bhqk', qb, k).astype(jnp.float32) * scale
        q_pos = start + jnp.arange(BLOCK_Q)
        before = key_pos[None, :] < q_pos[:, None]
        log_beta = jax.nn.log_sigmoid(z)
        log_keep = jnp.where(before, jax.nn.log_sigmoid(-z), 0.0)
        log_stick = lax.cumsum(log_keep, axis=3, reverse=True) - log_keep
        w = jnp.where(before, jnp.exp(log_beta + log_stick), 0.0)
        return jnp.einsum('bhqk,bhkd->bhqd', w.astype(v.dtype), v)

    return from_query_blocks(lax.map(block, (to_query_blocks(q), starts)))


def differential_attention(q1, k1, q2, k2, v, lam):
    s_len = q1.shape[2]
    scale = 1.0 / math.sqrt(DIFF_QK_DIM)
    key_pos = jnp.arange(s_len)
    starts = jnp.arange(s_len // BLOCK_Q) * BLOCK_Q

    def block(args):
        q1b, q2b, start = args
        q_pos = start + jnp.arange(BLOCK_Q)
        causal = key_pos[None, :] <= q_pos[:, None]
        s1 = jnp.einsum('bhqd,bhkd->bhqk', q1b, k1).astype(jnp.float32) * scale
        s2 = jnp.einsum('bhqd,bhkd->bhqk', q2b, k2).astype(jnp.float32) * scale
        p1 = jax.nn.softmax(jnp.where(causal, s1, -jnp.inf), axis=-1)
        p2 = jax.nn.softmax(jnp.where(causal, s2, -jnp.inf), axis=-1)
        w = p1 - lam * p2
        return jnp.einsum('bhqk,bhkd->bhqd', w.astype(v.dtype), v)

    out = lax.map(block, (to_query_blocks(q1), to_query_blocks(q2), starts))
    return from_query_blocks(out)


def hybrid_mixer(x, positions, w_in, sb_norm_gain, df_lambda, df_subln_gain, w_o, lambda_init):
    b, s, _ = x.shape
    proj = x @ w_in
    offsets = list(np.cumsum(IN_SPLITS)[:-1])
    sb_q, sb_k, sb_v, df_q, df_k, df_v = jnp.split(proj, offsets, axis=-1)

    def heads(t, h, d):
        return t.reshape(b, s, h, d).transpose(0, 2, 1, 3)

    sb_o = stick_breaking_attention(heads(sb_q, SB_HEADS, SB_HEAD_DIM),
                                    heads(sb_k, SB_HEADS, SB_HEAD_DIM),
                                    heads(sb_v, SB_HEADS, SB_HEAD_DIM))
    sb_o = rms_norm(sb_o, sb_norm_gain)

    dq = df_q.reshape(b, s, DIFF_HEADS, 2, DIFF_QK_DIM).transpose(3, 0, 2, 1, 4)
    dk = df_k.reshape(b, s, DIFF_HEADS, 2, DIFF_QK_DIM).transpose(3, 0, 2, 1, 4)
    q1, q2 = rope_partial(dq[0], positions), rope_partial(dq[1], positions)
    k1, k2 = rope_partial(dk[0], positions), rope_partial(dk[1], positions)
    lf = df_lambda.astype(jnp.float32)
    lam = (jnp.exp(jnp.sum(lf[0] * lf[1])) - jnp.exp(jnp.sum(lf[2] * lf[3]))
           + lambda_init)
    df_o = differential_attention(q1, k1, q2, k2, heads(df_v, DIFF_HEADS, DIFF_V_DIM), lam)
    df_o = rms_norm(df_o, df_subln_gain) * (1.0 - lambda_init)

    mixed = jnp.concatenate([sb_o.reshape(b, s, SB_WIDTH),
                             df_o.reshape(b, s, DIFF_WIDTH)], axis=-1)
    return mixed @ w_o


def memory_cross_attention(x, mem, w_mq, w_mkv, w_mo):
    b, s, _ = x.shape
    m = mem.shape[1]
    q = (x @ w_mq).reshape(b, s, MEM_HEADS, MEM_HEAD_DIM)
    kv = (mem @ w_mkv).reshape(b, m, 2, MEM_HEADS, MEM_HEAD_DIM)
    k, v = kv[:, :, 0], kv[:, :, 1]
    scores = jnp.einsum('bshd,bmhd->bhsm', q, k).astype(jnp.float32) / math.sqrt(MEM_HEAD_DIM)
    p = jax.nn.softmax(scores, axis=-1)
    o = jnp.einsum('bhsm,bmhd->bshd', p.astype(v.dtype), v).reshape(b, s, D_MODEL)
    return o @ w_mo


def peer_ffn(x, w_pq, sub_keys, expert_u, expert_v):
    b, s, d = x.shape
    q = (x @ w_pq).reshape(b, s, PEER_HEADS, 2, PEER_HALF)
    s1 = jnp.einsum('bshd,nd->bshn', q[..., 0, :], sub_keys[0]).astype(jnp.float32)
    s2 = jnp.einsum('bshd,nd->bshn', q[..., 1, :], sub_keys[1]).astype(jnp.float32)
    v1, i1 = lax.top_k(s1, PEER_TOPK)
    v2, i2 = lax.top_k(s2, PEER_TOPK)
    cand = (v1[..., :, None] + v2[..., None, :]).reshape(b, s, PEER_HEADS, PEER_TOPK * PEER_TOPK)
    cand_idx = (i1[..., :, None] * N_KEYS + i2[..., None, :]).reshape(
        b, s, PEER_HEADS, PEER_TOPK * PEER_TOPK)
    top, pos = lax.top_k(cand, PEER_TOPK)
    idx = jnp.take_along_axis(cand_idx, pos, axis=-1)
    g = jax.nn.softmax(top, axis=-1)

    n_blk = (b * s) // PEER_TOKEN_BLOCK
    xb = x.reshape(n_blk, PEER_TOKEN_BLOCK, d)
    ib = idx.reshape(n_blk, PEER_TOKEN_BLOCK, PEER_HEADS, PEER_TOPK)
    gb = g.reshape(n_blk, PEER_TOKEN_BLOCK, PEER_HEADS, PEER_TOPK)

    def block(args):
        xt, it, gt = args
        u = jnp.take(expert_u, it, axis=0)
        h = jnp.einsum('chkd,cd->chk', u, xt).astype(jnp.float32)
        a = gt * jax.nn.gelu(h, approximate=False)
        vv = jnp.take(expert_v, it, axis=0)
        return jnp.einsum('chk,chkd->cd', a.astype(x.dtype), vv)

    return lax.map(block, (xb, ib, gb)).reshape(b, s, d)


def setup_inputs(seed: int = 0) -> dict:
    key = jax.random.key(seed)
    ks = jax.random.split(key, 24)
    f32 = jnp.float32
    beta = DEEPNORM_BETA
    nrm = lambda k, shape: jax.random.normal(k, shape, dtype=f32)

    col_scale = jnp.concatenate([jnp.ones((2 * SB_WIDTH,), f32), beta * jnp.ones((SB_WIDTH,), f32),
                                 jnp.ones((2 * DIFF_Q_WIDTH,), f32), beta * jnp.ones((DIFF_WIDTH,), f32)])
    mkv_scale = jnp.concatenate([jnp.ones((D_MODEL,), f32), beta * jnp.ones((D_MODEL,), f32)])
    return {
        "x": nrm(ks[0], (BATCH, SEQ, D_MODEL)),
        "mem": nrm(ks[1], (BATCH, MEM_LEN, D_MODEL)),
        "w_in": nrm(ks[2], (DEPTH, D_MODEL, IN_WIDTH)) * (D_MODEL ** -0.5) * col_scale,
        "sb_norm_gain": 1.0 + 0.02 * nrm(ks[3], (DEPTH, SB_HEADS, SB_HEAD_DIM)),
        "df_lambda": 0.1 * nrm(ks[4], (DEPTH, 4, DIFF_QK_DIM)),
        "df_subln_gain": 1.0 + 0.02 * nrm(ks[5], (DEPTH, DIFF_V_DIM)),
        "w_o": nrm(ks[6], (DEPTH, MIX_WIDTH, D_MODEL)) * (MIX_WIDTH ** -0.5) * beta,
        "ln1_gain": 1.0 + 0.02 * nrm(ks[7], (DEPTH, D_MODEL)),
        "ln1_bias": 0.02 * nrm(ks[8], (DEPTH, D_MODEL)),
        "w_mq": nrm(ks[9], (DEPTH, D_MODEL, D_MODEL)) * (D_MODEL ** -0.5),
        "w_mkv": nrm(ks[10], (DEPTH, D_MODEL, 2 * D_MODEL)) * (D_MODEL ** -0.5) * mkv_scale,
        "w_mo": nrm(ks[11], (DEPTH, D_MODEL, D_MODEL)) * (D_MODEL ** -0.5) * beta,
        "ln2_gain": 1.0 + 0.02 * nrm(ks[12], (DEPTH, D_MODEL)),
        "ln2_bias": 0.02 * nrm(ks[13], (DEPTH, D_MODEL)),
        "w_pq": nrm(ks[14], (DEPTH, D_MODEL, PEER_HEADS * PEER_QUERY_DIM)) * (D_MODEL ** -0.5),
        "peer_sub_keys": nrm(ks[15], (DEPTH, 2, N_KEYS, PEER_HALF)) * (PEER_HALF ** -0.5),
        "peer_u": nrm(ks[16], (DEPTH, N_EXPERTS, D_MODEL)) * (D_MODEL ** -0.5),
        "peer_v": nrm(ks[17], (DEPTH, N_EXPERTS, D_MODEL)) * beta,
        "ln3_gain": 1.0 + 0.02 * nrm(ks[18], (DEPTH, D_MODEL)),
        "ln3_bias": 0.02 * nrm(ks[19], (DEPTH, D_MODEL)),
    }


def reference(x, mem, w_in, sb_norm_gain, df_lambda, df_subln_gain, w_o, ln1_gain, ln1_bias,
              w_mq, w_mkv, w_mo, ln2_gain, ln2_bias, w_pq, peer_sub_keys, peer_u, peer_v,
              ln3_gain, ln3_bias):
    positions = jnp.arange(x.shape[1])
    for l in range(DEPTH):
        lambda_init = 0.8 - 0.6 * math.exp(-0.3 * l)
        mix = hybrid_mixer(x, positions, w_in[l], sb_norm_gain[l], df_lambda[l],
                           df_subln_gain[l], w_o[l], lambda_init)
        x = layer_norm(DEEPNORM_ALPHA * x + mix, ln1_gain[l], ln1_bias[l])
        xa = memory_cross_attention(x, mem, w_mq[l], w_mkv[l], w_mo[l])
        x = layer_norm(DEEPNORM_ALPHA * x + xa, ln2_gain[l], ln2_bias[l])
        ff = peer_ffn(x, w_pq[l], peer_sub_keys[l], peer_u[l], peer_v[l])
        x = layer_norm(DEEPNORM_ALPHA * x + ff, ln3_gain[l], ln3_bias[l])
    return x
```

```cpp
#include <hip/hip_runtime.h>
#include <hip/hip_cooperative_groups.h>
#include <cstdio>
#include <cstdint>
namespace cg = cooperative_groups;

#ifndef N_LAUNCH_MODE
#define N_LAUNCH_MODE 1
#endif
#ifndef ATTN_FAST
#define ATTN_FAST 1
#endif
#ifndef XATTN_FAST
#define XATTN_FAST 1
#endif

#define LAS __attribute__((address_space(3)))
#define GAS __attribute__((address_space(1)))
typedef unsigned short bf16_t;
typedef short bf16x8 __attribute__((ext_vector_type(8)));
typedef short s16x4 __attribute__((ext_vector_type(4)));
typedef float f32x2 __attribute__((ext_vector_type(2)));
typedef float f32x4 __attribute__((ext_vector_type(4)));
typedef float f32x16 __attribute__((ext_vector_type(16)));
typedef unsigned u32x2 __attribute__((ext_vector_type(2)));
typedef unsigned u32x4 __attribute__((ext_vector_type(4)));
typedef __bf16 bf16x2_t __attribute__((ext_vector_type(2)));

constexpr int SEQ = 8192, DM = 2048, MEM = 256, INW = 6144, NEXP = 16384;
constexpr float ALPHA = 1.189207115002721f;
constexpr float LOG2E = 1.4426950408889634f;
constexpr float C_SB = 0.12751743082459868f;
constexpr float C_DF = 0.18033688011112042f;
constexpr float C_XA = 0.06375871541229934f;
constexpr float LAMBDA_INIT = 0.2f;
constexpr float LN_EPS = 1e-5f, RMS_EPS = 1e-6f;
constexpr int NWAVES = 8, NTHREADS = 512;

constexpr size_t MiB = 1u << 20;
constexpr size_t WS_CTL = 0;
constexpr size_t WS_ROPE = 1 * MiB;
constexpr size_t WS_KEYS = 1 * MiB + 512 * 1024;
constexpr size_t WS_MEMB = 2 * MiB;
constexpr size_t WS_KM = 3 * MiB;
constexpr size_t WS_VMT = 4 * MiB;
constexpr size_t WS_WIN = 8 * MiB;
constexpr size_t WS_WO = 32 * MiB;
constexpr size_t WS_WMQ = 40 * MiB;
constexpr size_t WS_WMKV = 48 * MiB;
constexpr size_t WS_WMO = 64 * MiB;
constexpr size_t WS_WPQ = 72 * MiB;
constexpr size_t WS_XB = 80 * MiB;
constexpr size_t WS_QP = 80 * MiB;
constexpr size_t WS_PROJ = 112 * MiB;
constexpr size_t WS_QM = 112 * MiB, WS_OM = 144 * MiB, WS_X2 = 176 * MiB;
constexpr size_t WS_MT = 196 * MiB;
constexpr size_t WS_VWT = 192 * MiB;
constexpr size_t WS_PART = 176 * MiB;
constexpr size_t WS_P1 = 204 * MiB, WS_P2 = 204 * MiB + 256 * 1024, WS_C12 = 204 * MiB + 512 * 1024, WS_MR = 204 * MiB + 576 * 1024, WS_PS = 205 * MiB;
constexpr size_t WS_MIX = 208 * MiB;
constexpr size_t WS_Y = 240 * MiB;
constexpr size_t WS_X1 = 304 * MiB;
constexpr size_t WS_UT = 344 * MiB;
constexpr size_t WS_VT = 376 * MiB;
constexpr size_t WS_END = 409 * MiB;
constexpr size_t PROJ_SEC = (size_t)SEQ * 1024;
constexpr int CW_LAM = 16;

constexpr int LDS_BYTES = 147456;

__device__ __forceinline__ unsigned f2bf(float f) { unsigned u = __builtin_bit_cast(unsigned, f); return (u + 0x7fffu + ((u >> 16) & 1u)) >> 16; }
__device__ __forceinline__ unsigned pk2(float lo, float hi) { return f2bf(lo) | (f2bf(hi) << 16); }
__device__ __forceinline__ unsigned cvtpk(float lo, float hi) { unsigned r; asm volatile("v_cvt_pk_bf16_f32 %0, %1, %2" : "=v"(r) : "v"(lo), "v"(hi)); return r; }
__device__ __forceinline__ unsigned fbits(float f) { return __builtin_bit_cast(unsigned, f); }
__device__ __forceinline__ float bitsf(unsigned u) { return __builtin_bit_cast(float, u); }
__device__ __forceinline__ float bflo(unsigned w) { return __builtin_bit_cast(float, w << 16); }
__device__ __forceinline__ float bfhi(unsigned w) { return __builtin_bit_cast(float, w & 0xffff0000u); }
__device__ __forceinline__ float bf1(bf16_t h) { return __builtin_bit_cast(float, (unsigned)h << 16); }
__device__ __forceinline__ float dpp_xor1(float v) { return __builtin_bit_cast(float, __builtin_amdgcn_update_dpp(0, __builtin_bit_cast(int, v), 0xB1, 0xF, 0xF, true)); }
__device__ __forceinline__ float dpp_xor2(float v) { return __builtin_bit_cast(float, __builtin_amdgcn_update_dpp(0, __builtin_bit_cast(int, v), 0x4E, 0xF, 0xF, true)); }
__device__ __forceinline__ float wave_sum(float v) {
    v += dpp_xor1(v); v += dpp_xor2(v);
    v += __builtin_bit_cast(float, __builtin_amdgcn_update_dpp(0, __builtin_bit_cast(int, v), 0x141, 0xF, 0xF, true));
    v += __builtin_bit_cast(float, __builtin_amdgcn_update_dpp(0, __builtin_bit_cast(int, v), 0x140, 0xF, 0xF, true));
    const int b = __builtin_bit_cast(int, v);
    return (__builtin_bit_cast(float, __builtin_amdgcn_readlane(b, 0)) + __builtin_bit_cast(float, __builtin_amdgcn_readlane(b, 16)))
         + (__builtin_bit_cast(float, __builtin_amdgcn_readlane(b, 32)) + __builtin_bit_cast(float, __builtin_amdgcn_readlane(b, 48)));
}
__device__ __forceinline__ float lane_xor16(float v) { float v2 = v; asm volatile("" : "+v"(v2));
    auto rr = __builtin_amdgcn_permlane16_swap(__builtin_bit_cast(unsigned, v), __builtin_bit_cast(unsigned, v2), false, false);
    const unsigned a_ = rr[0], b_ = rr[1]; return __builtin_bit_cast(float, (threadIdx.x & 16) ? a_ : b_); }
__device__ __forceinline__ float lane_xor32(float v) { float v2 = v; asm volatile("" : "+v"(v2));
    auto rr = __builtin_amdgcn_permlane32_swap(__builtin_bit_cast(unsigned, v), __builtin_bit_cast(unsigned, v2), false, false);
    const unsigned a_ = rr[0], b_ = rr[1]; return __builtin_bit_cast(float, (threadIdx.x & 32) ? a_ : b_); }
__device__ __forceinline__ float half32_sum(float v) {
    v += dpp_xor1(v); v += dpp_xor2(v);
    v += __builtin_bit_cast(float, __builtin_amdgcn_update_dpp(0, __builtin_bit_cast(int, v), 0x141, 0xF, 0xF, true));
    v += __builtin_bit_cast(float, __builtin_amdgcn_update_dpp(0, __builtin_bit_cast(int, v), 0x140, 0xF, 0xF, true));
    return v + lane_xor16(v);
}
__device__ __forceinline__ float wave_max(float v) {
#pragma unroll
    for (int o = 1; o < 64; o <<= 1) v = fmaxf(v, __shfl_xor(v, o));
    return v;
}
__device__ __forceinline__ float dot2bf(unsigned w, unsigned x, float acc) {
    return __builtin_amdgcn_fdot2_f32_bf16(__builtin_bit_cast(bf16x2_t, w), __builtin_bit_cast(bf16x2_t, x), acc, false);
}
__device__ __forceinline__ int crow(int r, int hi) { return (r & 3) + 8 * (r >> 2) + 4 * hi; }
#define LDS_WAIT() asm volatile("s_waitcnt lgkmcnt(0)" ::: "memory")
#define VM_WAIT() asm volatile("s_waitcnt vmcnt(0)" ::: "memory")

namespace pg8 {
constexpr int BM = 256, BK = 64, HALF = 128, HTB = HALF * BK * 2, STAGE_BYTES = 8 * HTB, NXCD = 8, WGM = 8;
__host__ __device__ __forceinline__ int lds_byte(int r, int c) { const int st = (r >> 4) * 2 + (c >> 5), rr = r & 15, cc = c & 31, ob = rr * 64 + cc * 2; return st * 1024 + (ob ^ (((ob >> 9) & 1) << 5)); }
__host__ __device__ __forceinline__ void stage_rc(int b, int& R, int& C) { const int st = b / 1024, sb = b % 1024, swz = sb ^ (((sb >> 9) & 1) << 5); R = (st >> 1) * 16 + swz / 64; C = (st & 1) * 32 + (swz % 64) / 2; }
__host__ __device__ __forceinline__ int perm32(int rho) { const int n = rho >> 4, i = rho & 15; return 8 * (i >> 2) + 4 * n + (i & 3); }

struct Unit { int pm, pn, kind; const char* A; const char* B; };
struct Gemm { int K, lda, ldb; };

__device__ __forceinline__ bool tile_of(long L, int nM, int nN, int& pm, int& pn) {
    const int nwg = nM * nN; if (L >= nwg) return false;
    int wgid = (int)L; { const int q = nwg / NXCD, r = nwg % NXCD, xcd = wgid % NXCD, off = wgid / NXCD; wgid = (xcd < r ? xcd * (q + 1) : r * (q + 1) + (xcd - r) * q) + off; }
    const int nig = WGM * nN, gid = wgid / nig, fm = gid * WGM, gsz = (nM - fm) < WGM ? (nM - fm) : WGM;
    pm = fm + ((wgid % nig) % gsz); pn = (wgid % nig) / gsz; return true;
}

template <class Epi, class Sched>
__device__ __forceinline__ void gemm_phase(LAS unsigned char* lds, const Gemm g, const Sched& S, const Epi& E) {
    const int tid = threadIdx.x, wid = __builtin_amdgcn_readfirstlane(tid >> 6), lane = tid & 63, wr = wid >> 2, wc = wid & 3, fr = lane & 15, fq = lane >> 4;
    const int K = g.K, nt = K / BK;
    unsigned voffA[2], voffB[2];
#pragma unroll
    for (int i = 0; i < 2; ++i) { int R, C; stage_rc(tid * 16 + i * 8192, R, C); const int Rb = (R & ~31) + perm32(R & 31);
        voffA[i] = (unsigned)(R * g.lda + C) * 2u; voffB[i] = (unsigned)(Rb * g.ldb + C) * 2u; }
    const size_t kstep = (size_t)(BK * 2);
    const size_t hstepA = (size_t)HALF * g.lda * 2, hstepB = (size_t)HALF * g.ldb * 2;
    const unsigned ldsw = (unsigned)wid * 1024u;
    const int aoff = lds_byte(wr * 64 + fr, fq * 8), boff = lds_byte(wc * 32 + fr, fq * 8);
#define PG8_SA(b, h) (((b) * 2 + (h)) * HTB)
#define PG8_SB(b, h) ((4 + (b) * 2 + (h)) * HTB)
#define PG8_STAGE(bufoff, gbase, voff) do { _Pragma("unroll") for (int _i = 0; _i < 2; ++_i) \
        __builtin_amdgcn_global_load_lds((const unsigned*)((const char*)(gbase) + (voff)[_i]), (LAS unsigned*)(lds + (bufoff) + ldsw + _i * 8192), 16, 0, 0); } while (0)
#define PG8_LDA(dst, b, h) do { _Pragma("unroll") for (int m = 0; m < 4; ++m) _Pragma("unroll") for (int k = 0; k < 2; ++k) dst[m][k] = *(const LAS bf16x8*)(lds + PG8_SA(b, h) + aoff + m * 2048 + k * 1024); } while (0)
#define PG8_LDB(dst, b, h) do { _Pragma("unroll") for (int n = 0; n < 2; ++n) _Pragma("unroll") for (int k = 0; k < 2; ++k) dst[n][k] = *(const LAS bf16x8*)(lds + PG8_SB(b, h) + boff + n * 2048 + k * 1024); } while (0)
#define PG8_MMA(ai, bj, At, Bt) do { __builtin_amdgcn_s_setprio(1); _Pragma("unroll") for (int m = 0; m < 4; ++m) _Pragma("unroll") for (int n = 0; n < 2; ++n) _Pragma("unroll") for (int k = 0; k < 2; ++k) \
        acc[ai][bj][m][n] = __builtin_amdgcn_mfma_f32_16x16x32_bf16(Bt[n][k], At[m][k], acc[ai][bj][m][n], 0, 0, 0); __builtin_amdgcn_s_setprio(0); } while (0)
#define PG8_WAIT_V(n) asm volatile("s_waitcnt vmcnt(" #n ")" ::: "memory")
#define PG8_WAIT_L(n) asm volatile("s_waitcnt lgkmcnt(" #n ")" ::: "memory")
#define PG8_BAR __builtin_amdgcn_s_barrier()
#define PG8_SCHED __builtin_amdgcn_sched_barrier(0)
    Unit cur, nxt; int ui = 0;
    if (!S.next(0, cur)) return;
    f32x4 acc[2][2][4][2];
#pragma unroll
    for (int a = 0; a < 2; ++a)
#pragma unroll
        for (int b = 0; b < 2; ++b)
#pragma unroll
            for (int m = 0; m < 4; ++m)
#pragma unroll
                for (int n = 0; n < 2; ++n) acc[a][b][m][n] = (f32x4){0.f, 0.f, 0.f, 0.f};
    bf16x8 At[4][2], B0[2][2], B1[2][2];
    const char* cA = cur.A; const char* cB = cur.B;
    PG8_STAGE(PG8_SB(0, 0), cB, voffB); PG8_STAGE(PG8_SB(0, 1), cB + hstepB, voffB); PG8_STAGE(PG8_SA(0, 0), cA, voffA); PG8_STAGE(PG8_SA(0, 1), cA + hstepA, voffA);
    if (wr == 1) PG8_BAR;
    PG8_WAIT_V(2); PG8_BAR;
    PG8_STAGE(PG8_SB(1, 0), cB + kstep, voffB); PG8_STAGE(PG8_SA(1, 0), cA + kstep, voffA); PG8_STAGE(PG8_SB(1, 1), cB + hstepB + kstep, voffB);
    PG8_WAIT_V(6); PG8_BAR;
    for (;;) {
        const bool has_next = S.next(ui + 1, nxt);
        const char* nA = has_next ? nxt.A : cA; const char* nB = has_next ? nxt.B : cB;
        for (int t = 0; t < nt; t += 2) {
            const bool last = (t == nt - 2);
            const char* a1 = cA + (size_t)(t + 1) * kstep;
            const char* a2 = last ? nA : cA + (size_t)(t + 2) * kstep; const char* b2 = last ? nB : cB + (size_t)(t + 2) * kstep;
            const char* a3 = a2 + kstep; const char* b3 = b2 + kstep;
            PG8_LDB(B0, 0, 0); PG8_LDB(B1, 0, 1); PG8_SCHED; PG8_LDA(At, 0, 0); PG8_STAGE(PG8_SA(1, 1), a1 + hstepA, voffA);
            PG8_WAIT_V(8); PG8_WAIT_L(0); PG8_BAR; PG8_MMA(0, 0, At, B0); PG8_MMA(0, 1, At, B1); PG8_BAR; PG8_SCHED;
            PG8_LDA(At, 0, 1); PG8_STAGE(PG8_SB(0, 0), b2, voffB); PG8_STAGE(PG8_SB(0, 1), b2 + hstepB, voffB); PG8_STAGE(PG8_SA(0, 0), a2, voffA);
            PG8_WAIT_V(8); PG8_WAIT_L(0); PG8_BAR; PG8_MMA(1, 0, At, B0); PG8_MMA(1, 1, At, B1); PG8_BAR; PG8_SCHED;
            PG8_LDB(B0, 1, 0); PG8_LDB(B1, 1, 1); PG8_SCHED; PG8_LDA(At, 1, 0); PG8_STAGE(PG8_SA(0, 1), a2 + hstepA, voffA);
            PG8_WAIT_V(8); PG8_WAIT_L(0); PG8_BAR; PG8_MMA(0, 0, At, B0); PG8_MMA(0, 1, At, B1); PG8_BAR; PG8_SCHED;
            PG8_LDA(At, 1, 1); PG8_STAGE(PG8_SB(1, 0), b3, voffB); PG8_STAGE(PG8_SB(1, 1), b3 + hstepB, voffB); PG8_STAGE(PG8_SA(1, 0), a3, voffA);
            PG8_WAIT_V(8); PG8_WAIT_L(0); PG8_BAR; PG8_MMA(1, 0, At, B0); PG8_MMA(1, 1, At, B1); PG8_BAR; PG8_SCHED;
        }
        if (wr == 0) PG8_BAR;
        E(acc, cur, wr, wc, fr, fq);
        if (!has_next) break;
#pragma unroll
        for (int a = 0; a < 2; ++a)
#pragma unroll
            for (int b = 0; b < 2; ++b)
#pragma unroll
                for (int m = 0; m < 4; ++m)
#pragma unroll
                    for (int n = 0; n < 2; ++n) acc[a][b][m][n] = (f32x4){0.f, 0.f, 0.f, 0.f};
        cur = nxt; cA = nA; cB = nB; ++ui;
        if (wr == 1) PG8_BAR;
    }
    PG8_WAIT_V(0);
    PG8_BAR;
#undef PG8_SA
#undef PG8_SB
#undef PG8_STAGE
#undef PG8_LDA
#undef PG8_LDB
#undef PG8_MMA
#undef PG8_WAIT_V
#undef PG8_WAIT_L
#undef PG8_BAR
#undef PG8_SCHED
}
}

struct Args {
    const float* in[20];
    float* out;
    unsigned char* ws;
    int ph_lo, ph_hi;
};

struct SchedSimple {
    const char* A; const char* B; int nM, nN, G, c; size_t tA, tB;
    __device__ __forceinline__ bool next(int i, pg8::Unit& u) const {
        int pm, pn; if (!pg8::tile_of((long)i * G + c, nM, nN, pm, pn)) return false;
        u.pm = pm; u.pn = pn; u.kind = 0; u.A = A + (size_t)pm * tA; u.B = B + (size_t)pn * tB; return true;
    }
};
struct SchedP1 {
    const char* xb; const char* win; const char* memb; const char* wmkv; int G, c; int base, lim;
    __device__ __forceinline__ bool next(int i, pg8::Unit& u) const {
        const long L = (long)i * G + c + base; constexpr size_t T = (size_t)256 * DM * 2;
        if (L >= lim) return false;
        if (L < 768) { int pm, pn; pg8::tile_of(L, 32, 24, pm, pn); u.pm = pm; u.pn = pn; u.kind = 0; u.A = xb + (size_t)pm * T; u.B = win + (size_t)pn * T; return true; }
        const int e = (int)(L - 768);
        if (e < 8) { u.pm = 0; u.pn = e; u.kind = 1; u.A = memb; u.B = wmkv + (size_t)e * T; return true; }
        if (e < 16) { u.pm = e - 8; u.pn = 0; u.kind = 2; u.A = wmkv + (size_t)(8 + e - 8) * T; u.B = memb; return true; }
        return false;
    }
};

__device__ __forceinline__ void st8(bf16_t* p, f32x4 v0, f32x4 v1, float sc) {
    u32x4 w; w.x = cvtpk(v0[0] * sc, v0[1] * sc); w.y = cvtpk(v0[2] * sc, v0[3] * sc); w.z = cvtpk(v1[0] * sc, v1[1] * sc); w.w = cvtpk(v1[2] * sc, v1[3] * sc);
    *(u32x4*)p = w;
}
struct SchedMKV {
    const char* memb; const char* wmkv; int c;
    __device__ __forceinline__ bool next(int i, pg8::Unit& u) const {
        if (i > 0) return false;
        const int e = c & 15, kc = c >> 4; constexpr size_t T = (size_t)256 * DM * 2; const size_t ko = (size_t)kc * 1024;
        if (e < 8) { u.pm = 0; u.pn = e; u.kind = 1 | (kc << 2); u.A = memb + ko; u.B = wmkv + (size_t)e * T + ko; return true; }
        u.pm = 0; u.pn = e - 8; u.kind = 2 | (kc << 2); u.A = memb + ko; u.B = wmkv + (size_t)e * T + ko; return true;
    }
};
struct EpiMKV {
    float* part;
    __device__ __forceinline__ void operator()(const f32x4 (&acc)[2][2][4][2], const pg8::Unit& u, int wr, int wc, int fr, int fq) const {
        const int kc = u.kind >> 2, k = u.kind & 3; const int ldc = DM;
        float* P = part + (size_t)kc * (1u << 20) + (k == 1 ? 0 : MEM * DM);
        const int row0 = u.pm * 256 + wr * 64 + fr, col0 = u.pn * 256 + wc * 32 + 8 * fq;
#pragma unroll
        for (int ai = 0; ai < 2; ++ai)
#pragma unroll
            for (int m = 0; m < 4; ++m) { float* rowp = P + (size_t)(row0 + ai * 128 + m * 16) * ldc + col0;
#pragma unroll
                for (int bj = 0; bj < 2; ++bj) { *(f32x4*)(rowp + bj * 128) = acc[ai][bj][m][0]; *(f32x4*)(rowp + bj * 128 + 4) = acc[ai][bj][m][1]; } }
    }
};
__device__ __forceinline__ void mkv_reduce(const float* part, bf16_t* km, bf16_t* vmt, int gtid, int nthr) {
    for (int uidx = gtid; uidx < 131072; uidx += nthr) {
        const size_t off = (size_t)uidx * 8;
        bf16_t* dst = uidx < 65536 ? km + (size_t)uidx * 8 : vmt + (size_t)(uidx - 65536) * 8;
        const float* p = part + off;
        const f32x4 a0 = *(const f32x4*)p, a1 = *(const f32x4*)(p + 4), b0 = *(const f32x4*)(p + (1u << 20)), b1 = *(const f32x4*)(p + (1u << 20) + 4);
        const f32x4 c0 = *(const f32x4*)(p + (2u << 20)), c1 = *(const f32x4*)(p + (2u << 20) + 4), d0 = *(const f32x4*)(p + (3u << 20)), d1 = *(const f32x4*)(p + (3u << 20) + 4);
        st8(dst, (a0 + b0) + (c0 + d0), (a1 + b1) + (c1 + d1), 1.f);
    }
}
struct SchedMT {
    const char* km; const char* wmq; int c;
    __device__ __forceinline__ bool next(int i, pg8::Unit& u) const {
        if (i > 0) return false;
        const int h = c >> 3, pn = c & 7;
        u.pm = h; u.pn = pn; u.kind = 0; u.A = km + (size_t)h * 512 * 2; u.B = wmq + ((size_t)pn * 256 * DM + (size_t)h * 512) * 2; return true;
    }
};
struct EpiSoftmaxP {
    bf16_t* PB; LAS unsigned char* lds;
    __device__ __forceinline__ void operator()(const f32x4 (&acc)[2][2][4][2], const pg8::Unit& u, int wr, int wc, int fr, int fq) const {
        LAS float* pmax = (LAS float*)(lds + 131072); LAS float* psum = (LAS float*)(lds + 131072 + 4096);
        const int row0 = u.pm * 256 + wr * 64 + fr, col0 = u.pn * 256 + wc * 32 + 8 * fq;
        float mx[2][4], iv[2][4];
#pragma unroll
        for (int ai = 0; ai < 2; ++ai)
#pragma unroll
            for (int m = 0; m < 4; ++m) { float v = -1e30f;
#pragma unroll
                for (int bj = 0; bj < 2; ++bj)
#pragma unroll
                    for (int n = 0; n < 2; ++n) { const f32x4 t = acc[ai][bj][m][n]; v = fmaxf(v, fmaxf(fmaxf(t.x, t.y), fmaxf(t.z, t.w))); }
                v = fmaxf(v, lane_xor16(v)); v = fmaxf(v, lane_xor32(v));
                if (fq == 0) pmax[(wr * 4 + wc) * 128 + ai * 64 + m * 16 + fr] = v; }
        __syncthreads();
#pragma unroll
        for (int ai = 0; ai < 2; ++ai)
#pragma unroll
            for (int m = 0; m < 4; ++m) { const int li = ai * 64 + m * 16 + fr;
                const float v = fmaxf(fmaxf(pmax[(wr * 4 + 0) * 128 + li], pmax[(wr * 4 + 1) * 128 + li]), fmaxf(pmax[(wr * 4 + 2) * 128 + li], pmax[(wr * 4 + 3) * 128 + li]));
                mx[ai][m] = v; float sm = 0.f;
#pragma unroll
                for (int bj = 0; bj < 2; ++bj)
#pragma unroll
                    for (int n = 0; n < 2; ++n) { const f32x4 t = acc[ai][bj][m][n];
                        sm += (__builtin_amdgcn_exp2f(t.x - v) + __builtin_amdgcn_exp2f(t.y - v)) + (__builtin_amdgcn_exp2f(t.z - v) + __builtin_amdgcn_exp2f(t.w - v)); }
                sm += lane_xor16(sm); sm += lane_xor32(sm);
                if (fq == 0) psum[(wr * 4 + wc) * 128 + li] = sm; }
        __syncthreads();
#pragma unroll
        for (int ai = 0; ai < 2; ++ai)
#pragma unroll
            for (int m = 0; m < 4; ++m) { const int li = ai * 64 + m * 16 + fr;
                iv[ai][m] = 1.f / ((psum[(wr * 4 + 0) * 128 + li] + psum[(wr * 4 + 1) * 128 + li]) + (psum[(wr * 4 + 2) * 128 + li] + psum[(wr * 4 + 3) * 128 + li])); }
#pragma unroll
        for (int ai = 0; ai < 2; ++ai)
#pragma unroll
            for (int m = 0; m < 4; ++m) { bf16_t* rowp = PB + (size_t)(row0 + ai * 128 + m * 16) * 1024 + col0; const float v = mx[ai][m], inv = iv[ai][m];
#pragma unroll
                for (int bj = 0; bj < 2; ++bj) { const f32x4 t0 = acc[ai][bj][m][0], t1 = acc[ai][bj][m][1];
                    const f32x4 e0 = {__builtin_amdgcn_exp2f(t0.x - v), __builtin_amdgcn_exp2f(t0.y - v), __builtin_amdgcn_exp2f(t0.z - v), __builtin_amdgcn_exp2f(t0.w - v)};
                    const f32x4 e1 = {__builtin_amdgcn_exp2f(t1.x - v), __builtin_amdgcn_exp2f(t1.y - v), __builtin_amdgcn_exp2f(t1.z - v), __builtin_amdgcn_exp2f(t1.w - v)};
                    st8(rowp + bj * 128, e0, e1, inv); } }
    }
};
struct SchedVW {
    const char* wmot; const char* vm; int c;
    __device__ __forceinline__ bool next(int i, pg8::Unit& u) const {
        if (i > 0) return false;
        const int pm = c & 7, h = c >> 3;
        u.pm = pm; u.pn = h; u.kind = 0; u.A = wmot + ((size_t)pm * 256 * DM + (size_t)h * 512) * 2; u.B = vm + (size_t)h * 512 * 2; return true;
    }
};
struct EpiBf16 {
    bf16_t* O; int ldc; float scale;
    __device__ __forceinline__ void operator()(const f32x4 (&acc)[2][2][4][2], const pg8::Unit& u, int wr, int wc, int fr, int fq) const {
        const int row0 = u.pm * 256 + wr * 64 + fr, col0 = u.pn * 256 + wc * 32 + 8 * fq;
#pragma unroll
        for (int ai = 0; ai < 2; ++ai)
#pragma unroll
            for (int m = 0; m < 4; ++m) { bf16_t* rowp = O + (size_t)(row0 + ai * 128 + m * 16) * ldc + col0;
#pragma unroll
                for (int bj = 0; bj < 2; ++bj) st8(rowp + bj * 128, acc[ai][bj][m][0], acc[ai][bj][m][1], scale); }
    }
};
struct EpiP1 {
    bf16_t* proj; bf16_t* km; bf16_t* vmt; const f32x2* rope;
    __device__ __forceinline__ void operator()(const f32x4 (&acc)[2][2][4][2], const pg8::Unit& u, int wr, int wc, int fr, int fq) const {
        if (u.kind != 0) {
            const int row0 = u.pm * 256 + wr * 64 + fr, col0 = u.pn * 256 + wc * 32 + 8 * fq;
#pragma unroll
            for (int ai = 0; ai < 2; ++ai)
#pragma unroll
                for (int m = 0; m < 4; ++m) { const int row = row0 + ai * 128 + m * 16;
#pragma unroll
                    for (int bj = 0; bj < 2; ++bj) { const int col = col0 + bj * 128;
                        const int unit = u.kind == 1 ? ((((col >> 9) * 32 + ((col & 511) >> 4)) * 8 + (row >> 5)) * 64 + ((col >> 3) & 1) * 32 + (row & 31))
                                                     : (((((row >> 9) * 4 + ((row >> 7) & 3)) * 16 + (col >> 4)) * 4 + ((row >> 5) & 3)) * 64 + ((col >> 3) & 1) * 32 + (row & 31));
                        st8((u.kind == 1 ? km : vmt) + (size_t)unit * 8, acc[ai][bj][m][0], acc[ai][bj][m][1], 1.f); } }
            return;
        }
        const int sec = u.pn >> 2, colt = (u.pn & 3) * 256;
        const float sc = sec == 0 ? C_SB : (sec == 3 ? C_DF : 1.f);
        const bool dorope = (sec == 3 || sec == 4) && ((wc & 1) == 0);
        bf16_t* O = proj + (size_t)sec * PROJ_SEC;
        const int row0 = u.pm * 256 + wr * 64 + fr, col0 = colt + wc * 32 + 8 * fq;
#pragma unroll
        for (int ai = 0; ai < 2; ++ai)
#pragma unroll
            for (int m = 0; m < 4; ++m) { const int row = row0 + ai * 128 + m * 16; bf16_t* rowp = O + (size_t)row * 1024 + col0;
#pragma unroll
                for (int bj = 0; bj < 2; ++bj) {
                    f32x4 v0 = acc[ai][bj][m][0], v1 = acc[ai][bj][m][1];
                    if (dorope) {
                        f32x4 o0, o1;
#pragma unroll
                        for (int j = 0; j < 4; ++j) { o0[j] = lane_xor16(v0[j]); o1[j] = lane_xor16(v1[j]); }
                        if (fq < 2) {
                            const f32x2* rp = rope + (size_t)row * 8; const float sg = fq == 0 ? -1.f : 1.f;
#pragma unroll
                            for (int j = 0; j < 4; ++j) { const f32x2 c0 = rp[j], c1 = rp[4 + j];
                                v0[j] = v0[j] * c0.x + sg * o0[j] * c0.y; v1[j] = v1[j] * c1.x + sg * o1[j] * c1.y; }
                        }
                    }
                    st8(rowp + bj * 128, v0, v1, sc);
                } }
    }
};
template <bool RES_BF16> struct EpiRes {
    const void* res; bf16_t* Y;
    __device__ __forceinline__ void operator()(const f32x4 (&acc)[2][2][4][2], const pg8::Unit& u, int wr, int wc, int fr, int fq) const {
        const int row0 = u.pm * 256 + wr * 64 + fr, col0 = u.pn * 256 + wc * 32 + 8 * fq;
#pragma unroll
        for (int ai = 0; ai < 2; ++ai)
#pragma unroll
            for (int m = 0; m < 4; ++m) { const size_t off = (size_t)(row0 + ai * 128 + m * 16) * DM + col0;
#pragma unroll
                for (int bj = 0; bj < 2; ++bj) { f32x4 r0, r1;
                    if (RES_BF16) { const u32x4 w = *(const u32x4*)((const bf16_t*)res + off + bj * 128);
                        r0 = (f32x4){bflo(w.x), bfhi(w.x), bflo(w.y), bfhi(w.y)}; r1 = (f32x4){bflo(w.z), bfhi(w.z), bflo(w.w), bfhi(w.w)}; }
                    else { r0 = *(const f32x4*)((const float*)res + off + bj * 128); r1 = *(const f32x4*)((const float*)res + off + bj * 128 + 4); }
                    const f32x4 y0 = r0 * ALPHA + acc[ai][bj][m][0], y1 = r1 * ALPHA + acc[ai][bj][m][1];
                    *(u32x4*)(Y + off + bj * 128) = (u32x4){cvtpk(y0.x, y0.y), cvtpk(y0.z, y0.w), cvtpk(y1.x, y1.y), cvtpk(y1.z, y1.w)}; } }
    }
};

struct EpiResStats {
    const bf16_t* res; bf16_t* Y; f32x2* PS;
    __device__ __forceinline__ void operator()(const f32x4 (&acc)[2][2][4][2], const pg8::Unit& u, int wr, int wc, int fr, int fq) const {
        const int row0 = u.pm * 256 + wr * 64 + fr, col0 = u.pn * 256 + wc * 32 + 8 * fq;
#pragma unroll
        for (int ai = 0; ai < 2; ++ai)
#pragma unroll
            for (int m = 0; m < 4; ++m) { const int row = row0 + ai * 128 + m * 16; const size_t off = (size_t)row * DM + col0; float s1 = 0.f, s2 = 0.f;
#pragma unroll
                for (int bj = 0; bj < 2; ++bj) { const u32x4 w = *(const u32x4*)(res + off + bj * 128);
                    const f32x4 r0 = (f32x4){bflo(w.x), bfhi(w.x), bflo(w.y), bfhi(w.y)}, r1 = (f32x4){bflo(w.z), bfhi(w.z), bflo(w.w), bfhi(w.w)};
                    const f32x4 y0 = r0 * ALPHA + acc[ai][bj][m][0], y1 = r1 * ALPHA + acc[ai][bj][m][1];
                    s1 += ((y0.x + y0.y) + (y0.z + y0.w)) + ((y1.x + y1.y) + (y1.z + y1.w));
                    s2 += ((y0.x * y0.x + y0.y * y0.y) + (y0.z * y0.z + y0.w * y0.w)) + ((y1.x * y1.x + y1.y * y1.y) + (y1.z * y1.z + y1.w * y1.w));
                    *(u32x4*)(Y + off + bj * 128) = (u32x4){cvtpk(y0.x, y0.y), cvtpk(y0.z, y0.w), cvtpk(y1.x, y1.y), cvtpk(y1.z, y1.w)}; }
                s1 += lane_xor16(s1); s2 += lane_xor16(s2); s1 += lane_xor32(s1); s2 += lane_xor32(s2);
                if (fq == 0) PS[(size_t)row * 32 + u.pn * 4 + wc] = (f32x2){s1, s2}; }
    }
};
struct EpiPQ {
    bf16_t* O; const f32x2* PS; const f32x2* C12; f32x2* MR;
    __device__ __forceinline__ void operator()(const f32x4 (&acc)[2][2][4][2], const pg8::Unit& u, int wr, int wc, int fr, int fq) const {
        const int row0 = u.pm * 256 + wr * 64 + fr, col0 = u.pn * 256 + wc * 32 + 8 * fq;
        float rs[2][4], mr[2][4];
#pragma unroll
        for (int ai = 0; ai < 2; ++ai)
#pragma unroll
            for (int m = 0; m < 4; ++m) { const int row = row0 + ai * 128 + m * 16; const f32x4* pp = (const f32x4*)(PS + (size_t)row * 32 + fq * 8);
                const f32x4 p0 = pp[0], p1 = pp[1], p2 = pp[2], p3 = pp[3];
                float s1 = ((p0.x + p0.z) + (p1.x + p1.z)) + ((p2.x + p2.z) + (p3.x + p3.z)), s2 = ((p0.y + p0.w) + (p1.y + p1.w)) + ((p2.y + p2.w) + (p3.y + p3.w));
                s1 += lane_xor16(s1); s2 += lane_xor16(s2); s1 += lane_xor32(s1); s2 += lane_xor32(s2);
                const float mean = s1 * (1.f / DM); const float var = fmaxf(s2 * (1.f / DM) - mean * mean, 0.f); const float rstd = 1.f / sqrtf(var + LN_EPS);
                rs[ai][m] = rstd; mr[ai][m] = rstd * mean;
                if (u.pn == 0 && wc == 0 && fq == 0) MR[row] = (f32x2){mean, rstd}; }
#pragma unroll
        for (int bj = 0; bj < 2; ++bj) { const f32x4* cp = (const f32x4*)(C12 + col0 + bj * 128); const f32x4 c0 = cp[0], c1 = cp[1], c2 = cp[2], c3 = cp[3];
#pragma unroll
            for (int ai = 0; ai < 2; ++ai)
#pragma unroll
                for (int m = 0; m < 4; ++m) { const float r = rs[ai][m], q = mr[ai][m]; const f32x4 a0 = acc[ai][bj][m][0], a1 = acc[ai][bj][m][1];
                    const f32x4 v0 = {a0.x * r - q * c0.x + c0.y, a0.y * r - q * c0.z + c0.w, a0.z * r - q * c1.x + c1.y, a0.w * r - q * c1.z + c1.w};
                    const f32x4 v1 = {a1.x * r - q * c2.x + c2.y, a1.y * r - q * c2.z + c2.w, a1.z * r - q * c3.x + c3.y, a1.w * r - q * c3.z + c3.w};
                    st8(O + (size_t)(row0 + ai * 128 + m * 16) * DM + col0 + bj * 128, v0, v1, 1.f); } }
    }
};

__device__ __forceinline__ void p0_transpose_item(const float* W, int K, int N, bf16_t* WT, LAS float* scr, int item, int lane) {
    const int nblk = N / 32, kb = item / nblk, nb = item % nblk, k0 = 64 * kb, n0 = 32 * nb;
#pragma unroll
    for (int i = 0; i < 32; ++i) { const int kk = 2 * i + (lane >> 5); scr[kk * 33 + (lane & 31)] = __builtin_nontemporal_load(&W[(size_t)(k0 + kk) * N + n0 + (lane & 31)]); }
    LDS_WAIT(); asm volatile("" ::: "memory");
    const int c = lane & 7;
#pragma unroll
    for (int j = 0; j < 4; ++j) { const int n = (lane >> 3) + 8 * j; const LAS float* s = scr + (8 * c) * 33 + n;
        u32x4 o; o.x = pk2(s[0 * 33], s[1 * 33]); o.y = pk2(s[2 * 33], s[3 * 33]); o.z = pk2(s[4 * 33], s[5 * 33]); o.w = pk2(s[6 * 33], s[7 * 33]);
        *(u32x4*)(WT + (size_t)(n0 + n) * K + k0 + 8 * c) = o; }
    LDS_WAIT(); asm volatile("" ::: "memory");
}
__device__ __forceinline__ void cvt_row_bf16(const float* src, bf16_t* dst, int lane) {
#pragma unroll
    for (int m = 0; m < 8; ++m) { const f32x4 v = __builtin_nontemporal_load(&((const f32x4*)src)[64 * m + lane]); ((u32x2*)dst)[64 * m + lane] = (u32x2){pk2(v.x, v.y), pk2(v.z, v.w)}; }
}
__device__ __forceinline__ void pq_transpose_item(const float* W, const float* gam, const float* bet, bf16_t* WT, float* P1, float* P2, LAS float* scr, int item, int lane) {
    constexpr int K = DM, N = DM; const int nblk = N / 32, kb = item / nblk, nb = item % nblk, k0 = 64 * kb, n0 = 32 * nb;
    float c1 = 0.f, c2 = 0.f;
#pragma unroll
    for (int i = 0; i < 32; ++i) { const int kk = 2 * i + (lane >> 5); const float w = __builtin_nontemporal_load(&W[(size_t)(k0 + kk) * N + n0 + (lane & 31)]); const float wg = w * gam[k0 + kk];
        scr[kk * 33 + (lane & 31)] = wg; c1 += bitsf(f2bf(wg) << 16); c2 += w * bet[k0 + kk]; }
    c1 += lane_xor32(c1); c2 += lane_xor32(c2);
    if (lane < 32) { P1[(size_t)kb * N + n0 + lane] = c1; P2[(size_t)kb * N + n0 + lane] = c2; }
    LDS_WAIT(); asm volatile("" ::: "memory");
    const int c = lane & 7;
#pragma unroll
    for (int j = 0; j < 4; ++j) { const int n = (lane >> 3) + 8 * j; const LAS float* sp = scr + (8 * c) * 33 + n;
        u32x4 o; o.x = pk2(sp[0 * 33], sp[1 * 33]); o.y = pk2(sp[2 * 33], sp[3 * 33]); o.z = pk2(sp[4 * 33], sp[5 * 33]); o.w = pk2(sp[6 * 33], sp[7 * 33]);
        *(u32x4*)(WT + (size_t)(n0 + n) * K + k0 + 8 * c) = o; }
    LDS_WAIT(); asm volatile("" ::: "memory");
}
constexpr int EROW = 1152;
__device__ __forceinline__ unsigned fp4_code(float y) { const float a = fabsf(y);
    const unsigned idx = a < 0.25f ? 0u : (a < 0.75f ? 1u : (a < 1.25f ? 2u : (a < 1.75f ? 3u : (a < 2.5f ? 4u : (a < 3.5f ? 5u : (a < 5.f ? 6u : 7u))))));
    return idx | (y < 0.f ? 8u : 0u); }
__device__ __forceinline__ void cvt_row_expert(const float* src, unsigned char* dst, int lane) {
    f32x4 v[8]; float mx = 0.f;
#pragma unroll
    for (int m = 0; m < 8; ++m) { v[m] = __builtin_nontemporal_load(&((const f32x4*)src)[64 * m + lane]);
        mx = fmaxf(mx, fmaxf(fmaxf(fabsf(v[m].x), fabsf(v[m].y)), fmaxf(fabsf(v[m].z), fabsf(v[m].w)))); }
    const unsigned sb = f2bf(mx > 0.f ? mx * (1.f / 6.f) : 1.f); const float sc = bitsf(sb << 16); const float inv = 1.f / sc;
    u32x4 w;
#pragma unroll
    for (int d = 0; d < 4; ++d) { unsigned p = 0;
        p = __builtin_amdgcn_cvt_scalef32_pk_fp4_f32(p, v[2 * d][0] * inv, v[2 * d + 1][0] * inv, 1.0f, 0);
        p = __builtin_amdgcn_cvt_scalef32_pk_fp4_f32(p, v[2 * d][1] * inv, v[2 * d + 1][1] * inv, 1.0f, 1);
        p = __builtin_amdgcn_cvt_scalef32_pk_fp4_f32(p, v[2 * d][2] * inv, v[2 * d + 1][2] * inv, 1.0f, 2);
        p = __builtin_amdgcn_cvt_scalef32_pk_fp4_f32(p, v[2 * d][3] * inv, v[2 * d + 1][3] * inv, 1.0f, 3);
        w[d] = p; }
    ((u32x4*)dst)[lane] = w;
    ((unsigned short*)(dst + 1024))[lane] = (unsigned short)sb;
}
__device__ __forceinline__ void cvt_expert_idx(const Args& a, int r, int lane) {
    if (r < NEXP) cvt_row_expert(a.in[16] + (size_t)r * DM, a.ws + WS_UT + (size_t)r * EROW, lane);
    else cvt_row_expert(a.in[17] + (size_t)(r - NEXP) * DM, a.ws + WS_VT + (size_t)(r - NEXP) * EROW, lane);
}
constexpr int NE_P0 = 2 * NEXP - 30720;
constexpr int NE_P4 = 1536;
constexpr int NE_T6 = 7168;
__device__ __forceinline__ void p0_prologue(const Args& a, LAS unsigned char* lds, int gw, int NGW, int wave, int lane) {
    unsigned char* ws = a.ws;
    LAS float* scr = (LAS float*)(lds + wave * 16384);
    constexpr int I_IN = 32 * (INW / 32), I_SQ = 32 * (DM / 32), I_KV = 32 * (4096 / 32);
    constexpr int T_END = I_IN + 4 * I_SQ + I_KV;
    constexpr int X_END = T_END + SEQ;
    constexpr int M_END = X_END + MEM;
    constexpr int K_END = M_END + 16;
    constexpr int E_END = K_END + 2 * NEXP;
    constexpr int R_END = E_END + 1024;
    for (int it = gw; it < R_END; it += NGW) {
        int r = it;
        if (r < T_END) {
            if (r < I_IN) { p0_transpose_item(a.in[2], DM, INW, (bf16_t*)(ws + WS_WIN), scr, r, lane); continue; } r -= I_IN;
            if (r < I_SQ) { continue; } r -= I_SQ;
            if (r < I_SQ) { continue; } r -= I_SQ;
            if (r < I_KV) { continue; } r -= I_KV;
            if (r < I_SQ) { continue; } r -= I_SQ;
            continue;
        }
        if (r < X_END) { r -= T_END; cvt_row_bf16(a.in[0] + (size_t)r * DM, (bf16_t*)(ws + WS_XB) + (size_t)r * DM, lane); continue; }
        if (r < M_END) { r -= X_END; cvt_row_bf16(a.in[1] + (size_t)r * DM, (bf16_t*)(ws + WS_MEMB) + (size_t)r * DM, lane); continue; }
        if (r < K_END) { r -= M_END; cvt_row_bf16(a.in[15] + (size_t)r * DM, (bf16_t*)(ws + WS_KEYS) + (size_t)r * DM, lane); continue; }
        if (r < E_END) { continue;
            r -= K_END; if (r >= NE_P0) continue;
            if (r < NEXP) cvt_row_expert(a.in[16] + (size_t)r * DM, ws + WS_UT + (size_t)r * EROW, lane);
            else { r -= NEXP; cvt_row_expert(a.in[17] + (size_t)r * DM, ws + WS_VT + (size_t)r * EROW, lane); }
            continue; }
        { r -= E_END; const int gid = r * 64 + lane, row = gid >> 3, i = gid & 7;
            const double fr_[8] = {0.15915494309189535, 0.03086376340470123, 0.005985185712713705, 0.001160663641240061,
                                   0.00022507907903927653, 4.364795279280289e-05, 8.464330808241401e-06, 1.6414262627950345e-06};
            double f = 0.0;
#pragma unroll
            for (int q = 0; q < 8; ++q) f = (i == q) ? fr_[q] : f;
            const double rev = (double)row * f; const float frac = (float)(rev - floor(rev));
            ((f32x2*)(ws + WS_ROPE))[gid] = (f32x2){__builtin_amdgcn_cosf(frac), __builtin_amdgcn_sinf(frac)}; }
    }
    if (gw == 0 && lane == 0) {
        const float* lf = a.in[4]; float s01 = 0.f, s23 = 0.f;
        for (int i = 0; i < 64; ++i) { s01 += lf[i] * lf[64 + i]; s23 += lf[128 + i] * lf[192 + i]; }
        ((float*)(ws + WS_CTL))[CW_LAM] = expf(s01) - expf(s23) + LAMBDA_INIT;
    }
}

__device__ __forceinline__ void p0_late(const Args& a, LAS unsigned char* lds, int gw, int NGW, int wave, int lane) {
    unsigned char* ws = a.ws; LAS float* scr = (LAS float*)(lds + wave * 16384);
    constexpr int I_SQ = 32 * (DM / 32), I_KV = 32 * (4096 / 32);
    for (int it = gw; it < 3 * I_SQ + I_KV; it += NGW) { int r = it;
        if (r < I_SQ) { p0_transpose_item(a.in[6], DM, DM, (bf16_t*)(ws + WS_WO), scr, r, lane); continue; } r -= I_SQ;
        if (r < I_KV) { p0_transpose_item(a.in[10], DM, 4096, (bf16_t*)(ws + WS_WMKV), scr, r, lane); continue; } r -= I_KV;
        if (r < I_SQ) { cvt_row_bf16(a.in[9] + (size_t)r * DM, (bf16_t*)(ws + WS_WMQ) + (size_t)r * DM, lane); continue; } r -= I_SQ;
        p0_transpose_item(a.in[11], DM, DM, (bf16_t*)(ws + WS_WMO), scr, r, lane); }
    for (int r = gw; r < NE_P0; r += NGW) cvt_expert_idx(a, r, lane);
}
__device__ __forceinline__ void ln_phase(const bf16_t* Y, bf16_t* X, const float* gain, const float* bias, int gw, int NGW, int lane) {
    f32x4 G0[4], G1[4], B0[4], B1[4];
#pragma unroll
    for (int j = 0; j < 4; ++j) { G0[j] = ((const f32x4*)gain)[128 * j + 2 * lane]; G1[j] = ((const f32x4*)gain)[128 * j + 2 * lane + 1]; B0[j] = ((const f32x4*)bias)[128 * j + 2 * lane]; B1[j] = ((const f32x4*)bias)[128 * j + 2 * lane + 1]; }
    for (int row = gw; row < SEQ; row += NGW) {
        const u32x4* yr = (const u32x4*)(Y + (size_t)row * DM) + lane;
        float v[4][8]; float s = 0.f;
#pragma unroll
        for (int j = 0; j < 4; ++j) { const u32x4 w = yr[64 * j];
            v[j][0] = bflo(w.x); v[j][1] = bfhi(w.x); v[j][2] = bflo(w.y); v[j][3] = bfhi(w.y); v[j][4] = bflo(w.z); v[j][5] = bfhi(w.z); v[j][6] = bflo(w.w); v[j][7] = bfhi(w.w);
            s += ((v[j][0] + v[j][1]) + (v[j][2] + v[j][3])) + ((v[j][4] + v[j][5]) + (v[j][6] + v[j][7])); }
        const float mean = wave_sum(s) * (1.f / DM); float s2 = 0.f;
#pragma unroll
        for (int j = 0; j < 4; ++j)
#pragma unroll
            for (int i = 0; i < 8; ++i) { v[j][i] -= mean; s2 += v[j][i] * v[j][i]; }
        const float rstd = 1.f / sqrtf(wave_sum(s2) * (1.f / DM) + LN_EPS);
        u32x4* o = (u32x4*)(X + (size_t)row * DM) + lane;
#pragma unroll
        for (int j = 0; j < 4; ++j) { const f32x4 g0 = G0[j], g1 = G1[j], b0 = B0[j], b1 = B1[j];
            o[64 * j] = (u32x4){pk2(v[j][0] * rstd * g0.x + b0.x, v[j][1] * rstd * g0.y + b0.y), pk2(v[j][2] * rstd * g0.z + b0.z, v[j][3] * rstd * g0.w + b0.w),
                                pk2(v[j][4] * rstd * g1.x + b1.x, v[j][5] * rstd * g1.y + b1.y), pk2(v[j][6] * rstd * g1.z + b1.z, v[j][7] * rstd * g1.w + b1.w)}; }
    }
}

__device__ __forceinline__ void attn_naive_phase(const Args& a, LAS unsigned char* lds, int gw, int NGW, int wave, int lane) {
    unsigned char* ws = a.ws;
    const bf16_t* proj = (const bf16_t*)(ws + WS_PROJ);
    const bf16_t* SBQ = proj, * SBK = proj + PROJ_SEC, * SBV = proj + 2 * PROJ_SEC, * DQ = proj + 3 * PROJ_SEC, * DK = proj + 4 * PROJ_SEC, * DV = proj + 5 * PROJ_SEC;
    bf16_t* MIX = (bf16_t*)(ws + WS_MIX);
    LAS float* qs = (LAS float*)(lds + wave * 1024);
    LAS float* wsm = (LAS float*)(lds + wave * 1024 + 512);
    const float lam = ((const float*)(ws + WS_CTL))[CW_LAM];
    for (int it = gw; it < SEQ * 16; it += NGW) {
        const int t = it >> 4, u = it & 15;
        if (u < 8) {
            const int h = u;
            { const unsigned w = *(const unsigned*)(SBQ + (size_t)t * 1024 + h * 128 + 2 * lane); qs[2 * lane] = bflo(w); qs[2 * lane + 1] = bfhi(w); }
            LDS_WAIT();
            float acc0 = 0.f, acc1 = 0.f, R = 0.f;
            for (int c0 = t - 1; c0 >= 0; c0 -= 64) {
                const int s = c0 - lane; const bool valid = s >= 0;
                float z = 0.f;
                if (valid) { const u32x4* kp = (const u32x4*)(SBK + (size_t)s * 1024 + h * 128);
                    for (int d = 0; d < 16; ++d) { const u32x4 kw = kp[d]; const LAS float* q8 = qs + 8 * d;
                        z += bflo(kw.x) * q8[0] + bfhi(kw.x) * q8[1] + bflo(kw.y) * q8[2] + bfhi(kw.y) * q8[3] + bflo(kw.z) * q8[4] + bfhi(kw.z) * q8[5] + bflo(kw.w) * q8[6] + bfhi(kw.w) * q8[7]; } }
                z = fminf(fmaxf(z, -126.f), 126.f);
                const float e = __builtin_amdgcn_exp2f(-z), l2 = __builtin_amdgcn_logf(1.f + e);
                const float lk = valid ? (-z - l2) : 0.f;
                float incl = lk;
#pragma unroll
                for (int off = 1; off < 64; off <<= 1) { const float tt = __shfl_up(incl, off); if (lane >= off) incl += tt; }
                const float w = valid ? __builtin_amdgcn_exp2f(R + (incl - lk) - l2) : 0.f;
                R += __shfl(incl, 63);
                wsm[lane] = w; LDS_WAIT();
                const int nk = c0 + 1 < 64 ? c0 + 1 : 64;
                for (int j = 0; j < nk; ++j) { const float wj = wsm[j]; const unsigned vw = *(const unsigned*)(SBV + (size_t)(c0 - j) * 1024 + h * 128 + 2 * lane);
                    acc0 += wj * bflo(vw); acc1 += wj * bfhi(vw); }
                LDS_WAIT();
            }
            const float ss = wave_sum(acc0 * acc0 + acc1 * acc1);
            const float rstd = 1.f / sqrtf(ss * (1.f / 128.f) + RMS_EPS);
            const float* g = a.in[3] + h * 128 + 2 * lane;
            *(unsigned*)(MIX + (size_t)t * DM + h * 128 + 2 * lane) = pk2(acc0 * rstd * g[0], acc1 * rstd * g[1]);
        } else {
            const int h = u - 8;
            { const unsigned w = *(const unsigned*)(DQ + (size_t)t * 1024 + h * 128 + 2 * lane); qs[2 * lane] = bflo(w); qs[2 * lane + 1] = bfhi(w); }
            LDS_WAIT();
            float r0[2], r1[2];
            for (int mp = 0; mp < 2; ++mp) {
                float acc0 = 0.f, acc1 = 0.f, m = -1e30f, l = 0.f;
                for (int c0 = 0; c0 <= t; c0 += 64) {
                    const int s = c0 + lane; const bool valid = s <= t;
                    float z = -__builtin_inff();
                    if (valid) { z = 0.f; const u32x4* kp = (const u32x4*)(DK + (size_t)s * 1024 + h * 128 + mp * 64);
                        for (int d = 0; d < 8; ++d) { const u32x4 kw = kp[d]; const LAS float* q8 = qs + mp * 64 + 8 * d;
                            z += bflo(kw.x) * q8[0] + bfhi(kw.x) * q8[1] + bflo(kw.y) * q8[2] + bfhi(kw.y) * q8[3] + bflo(kw.z) * q8[4] + bfhi(kw.z) * q8[5] + bflo(kw.w) * q8[6] + bfhi(kw.w) * q8[7]; } }
                    const float mn = fmaxf(m, wave_max(z)); const float al = __builtin_amdgcn_exp2f(m - mn); m = mn;
                    const float p = valid ? __builtin_amdgcn_exp2f(z - mn) : 0.f;
                    l = l * al + wave_sum(p); acc0 *= al; acc1 *= al;
                    wsm[lane] = p; LDS_WAIT();
                    const int nk = t - c0 + 1 < 64 ? t - c0 + 1 : 64;
                    for (int j = 0; j < nk; ++j) { const float wj = wsm[j]; const unsigned vw = *(const unsigned*)(DV + (size_t)(c0 + j) * 1024 + h * 128 + 2 * lane);
                        acc0 += wj * bflo(vw); acc1 += wj * bfhi(vw); }
                    LDS_WAIT();
                }
                r0[mp] = acc0 / l; r1[mp] = acc1 / l;
            }
            const float o0 = r0[0] - lam * r0[1], o1 = r1[0] - lam * r1[1];
            const float ss = wave_sum(o0 * o0 + o1 * o1);
            const float rstd = (1.f - LAMBDA_INIT) / sqrtf(ss * (1.f / 128.f) + RMS_EPS);
            const float* g = a.in[5] + 2 * lane;
            *(unsigned*)(MIX + (size_t)t * DM + 1024 + h * 128 + 2 * lane) = pk2(o0 * rstd * g[0], o1 * rstd * g[1]);
        }
    }
}


namespace fa {
constexpr int SHM_V = 64 * 128 * 2, SHM_K = 64 * 128 * 2;
constexpr float SB_STOP = -64.f;
#define FA_KSWZ(row, colB) ((row) * 256 + ((colB) ^ (((row) & 7) << 4)))
#define FA_SBAR() __builtin_amdgcn_sched_barrier(0)
__device__ __forceinline__ int v_st(int k, int c) { const int kk = (k & ~0xC) | ((k & 4) << 1) | ((k & 8) >> 1); return ((kk >> 3) * 4 + (c >> 5)) * 512 + ((kk & 7) * 32 + (c & 31)) * 2; }
__device__ __forceinline__ int v_rd_base(int lane) { return ((lane & 3) << 3) | (((lane >> 2) & 3) << 6) | (((lane >> 4) & 1) << 5) | (((lane >> 5) & 1) << 8); }
constexpr int v_rd_off(int d0, int ks, int half) { return d0 * 512 + ks * 4096 + half * 2048; }
template <int D0, int NK>
__device__ __forceinline__ void qkt(f32x16& p0, f32x16& p1, const char* Kb, int r32, int hi, const bf16x8* qr) {
    p0 = f32x16{}; p1 = f32x16{};
#pragma unroll
    for (int d = 0; d < NK; ++d) { const int cb = ((D0 + d) * 16 + hi * 8) * 2;
        const bf16x8 b0 = *reinterpret_cast<const bf16x8*>(Kb + FA_KSWZ(r32, cb));
        const bf16x8 b1 = *reinterpret_cast<const bf16x8*>(Kb + FA_KSWZ(32 + r32, cb));
        p0 = __builtin_amdgcn_mfma_f32_32x32x16_bf16(b0, qr[d], p0, 0, 0, 0);
        p1 = __builtin_amdgcn_mfma_f32_32x32x16_bf16(b1, qr[d], p1, 0, 0, 0); }
}
__device__ __forceinline__ void qkt_lq(f32x16& p0, f32x16& p1, const char* Kb, const char* Qw, int r32, int hi) {
    p0 = f32x16{}; p1 = f32x16{};
#pragma unroll
    for (int d = 0; d < 8; ++d) { const int cb = (d * 16 + hi * 8) * 2;
        const bf16x8 q = *reinterpret_cast<const bf16x8*>(Qw + FA_KSWZ(r32, cb));
        const bf16x8 b0 = *reinterpret_cast<const bf16x8*>(Kb + FA_KSWZ(r32, cb));
        const bf16x8 b1 = *reinterpret_cast<const bf16x8*>(Kb + FA_KSWZ(32 + r32, cb));
        p0 = __builtin_amdgcn_mfma_f32_32x32x16_bf16(b0, q, p0, 0, 0, 0);
        p1 = __builtin_amdgcn_mfma_f32_32x32x16_bf16(b1, q, p1, 0, 0, 0); }
}
__device__ __forceinline__ void pv_tile(f32x16* o, int vb0, bf16x8 pa0, bf16x8 pa1, bf16x8 pa2, bf16x8 pa3) {
#define FA_TRRD(dst, off) asm volatile("ds_read_b64_tr_b16 %0, %1 offset:%2" : "=&v"(dst) : "v"(vb0), "i"(off) : "memory")
#define FA_PV_RD(P_, d0) do { constexpr int b_ = v_rd_off(d0, 0, 0); \
        FA_TRRD(P_##l0, b_); FA_TRRD(P_##h0, b_ + 2048); FA_TRRD(P_##l1, b_ + 4096); FA_TRRD(P_##h1, b_ + 6144); FA_TRRD(P_##l2, b_ + 8192); FA_TRRD(P_##h2, b_ + 10240); FA_TRRD(P_##l3, b_ + 12288); FA_TRRD(P_##h3, b_ + 14336); } while (0)
#define FA_PV_MM(P_, d0) do { \
        o[d0] = __builtin_amdgcn_mfma_f32_32x32x16_bf16(pa0, (bf16x8){P_##l0[0], P_##l0[1], P_##l0[2], P_##l0[3], P_##h0[0], P_##h0[1], P_##h0[2], P_##h0[3]}, o[d0], 0, 0, 0); \
        o[d0] = __builtin_amdgcn_mfma_f32_32x32x16_bf16(pa1, (bf16x8){P_##l1[0], P_##l1[1], P_##l1[2], P_##l1[3], P_##h1[0], P_##h1[1], P_##h1[2], P_##h1[3]}, o[d0], 0, 0, 0); \
        o[d0] = __builtin_amdgcn_mfma_f32_32x32x16_bf16(pa2, (bf16x8){P_##l2[0], P_##l2[1], P_##l2[2], P_##l2[3], P_##h2[0], P_##h2[1], P_##h2[2], P_##h2[3]}, o[d0], 0, 0, 0); \
        o[d0] = __builtin_amdgcn_mfma_f32_32x32x16_bf16(pa3, (bf16x8){P_##l3[0], P_##l3[1], P_##l3[2], P_##l3[3], P_##h3[0], P_##h3[1], P_##h3[2], P_##h3[3]}, o[d0], 0, 0, 0); } while (0)
#define FA_PV_WAIT(n) do { asm volatile("s_waitcnt lgkmcnt(" #n ")" ::: "memory"); FA_SBAR(); } while (0)
    s16x4 Al0, Al1, Al2, Al3, Ah0, Ah1, Ah2, Ah3, Bl0, Bl1, Bl2, Bl3, Bh0, Bh1, Bh2, Bh3;
    FA_PV_RD(A, 0);
    FA_PV_RD(B, 1); FA_PV_WAIT(8); FA_PV_MM(A, 0); FA_SBAR();
    FA_PV_RD(A, 2); FA_PV_WAIT(8); FA_PV_MM(B, 1); FA_SBAR();
    FA_PV_RD(B, 3); FA_PV_WAIT(8); FA_PV_MM(A, 2); FA_SBAR();
    FA_PV_WAIT(0); FA_PV_MM(B, 3);
#undef FA_PV_RD
#undef FA_PV_MM
#undef FA_PV_WAIT
#undef FA_TRRD
}
__device__ __forceinline__ void pv_tile_s(f32x16* o, int vb0, bf16x8 pa0, bf16x8 pa1, bf16x8 pa2, bf16x8 pa3) {
#define FA_TRRD(dst, off) asm volatile("ds_read_b64_tr_b16 %0, %1 offset:%2" : "=&v"(dst) : "v"(vb0), "i"(off) : "memory")
#define FA_PV_D0(d0) do { s16x4 l0, l1, l2, l3, h0, h1, h2, h3; constexpr int b_ = v_rd_off(d0, 0, 0); \
        FA_TRRD(l0, b_); FA_TRRD(h0, b_ + 2048); FA_TRRD(l1, b_ + 4096); FA_TRRD(h1, b_ + 6144); FA_TRRD(l2, b_ + 8192); FA_TRRD(h2, b_ + 10240); FA_TRRD(l3, b_ + 12288); FA_TRRD(h3, b_ + 14336); \
        asm volatile("s_waitcnt lgkmcnt(0)" ::: "memory"); FA_SBAR(); \
        o[d0] = __builtin_amdgcn_mfma_f32_32x32x16_bf16(pa0, (bf16x8){l0[0], l0[1], l0[2], l0[3], h0[0], h0[1], h0[2], h0[3]}, o[d0], 0, 0, 0); \
        o[d0] = __builtin_amdgcn_mfma_f32_32x32x16_bf16(pa1, (bf16x8){l1[0], l1[1], l1[2], l1[3], h1[0], h1[1], h1[2], h1[3]}, o[d0], 0, 0, 0); \
        o[d0] = __builtin_amdgcn_mfma_f32_32x32x16_bf16(pa2, (bf16x8){l2[0], l2[1], l2[2], l2[3], h2[0], h2[1], h2[2], h2[3]}, o[d0], 0, 0, 0); \
        o[d0] = __builtin_amdgcn_mfma_f32_32x32x16_bf16(pa3, (bf16x8){l3[0], l3[1], l3[2], l3[3], h3[0], h3[1], h3[2], h3[3]}, o[d0], 0, 0, 0); } while (0)
    FA_PV_D0(0); FA_PV_D0(1); FA_PV_D0(2); FA_PV_D0(3);
#undef FA_PV_D0
#undef FA_TRRD
}
#define FA_PVK_TRRD(dst, off) asm volatile("ds_read_b64_tr_b16 %0, %1 offset:%2" : "=&v"(dst) : "v"(vbk_), "i"(off) : "memory")
#define FA_PVK_RD(S_, ks) do { FA_PVK_TRRD(S_##l0, v_rd_off(0, ks, 0)); FA_PVK_TRRD(S_##h0, v_rd_off(0, ks, 1)); FA_PVK_TRRD(S_##l1, v_rd_off(1, ks, 0)); FA_PVK_TRRD(S_##h1, v_rd_off(1, ks, 1)); \
        FA_PVK_TRRD(S_##l2, v_rd_off(2, ks, 0)); FA_PVK_TRRD(S_##h2, v_rd_off(2, ks, 1)); FA_PVK_TRRD(S_##l3, v_rd_off(3, ks, 0)); FA_PVK_TRRD(S_##h3, v_rd_off(3, ks, 1)); } while (0)
#define FA_PVK_MM(S_, pa_) do { \
        o[0] = __builtin_amdgcn_mfma_f32_32x32x16_bf16(pa_, (bf16x8){S_##l0[0], S_##l0[1], S_##l0[2], S_##l0[3], S_##h0[0], S_##h0[1], S_##h0[2], S_##h0[3]}, o[0], 0, 0, 0); \
        o[1] = __builtin_amdgcn_mfma_f32_32x32x16_bf16(pa_, (bf16x8){S_##l1[0], S_##l1[1], S_##l1[2], S_##l1[3], S_##h1[0], S_##h1[1], S_##h1[2], S_##h1[3]}, o[1], 0, 0, 0); \
        o[2] = __builtin_amdgcn_mfma_f32_32x32x16_bf16(pa_, (bf16x8){S_##l2[0], S_##l2[1], S_##l2[2], S_##l2[3], S_##h2[0], S_##h2[1], S_##h2[2], S_##h2[3]}, o[2], 0, 0, 0); \
        o[3] = __builtin_amdgcn_mfma_f32_32x32x16_bf16(pa_, (bf16x8){S_##l3[0], S_##l3[1], S_##l3[2], S_##l3[3], S_##h3[0], S_##h3[1], S_##h3[2], S_##h3[3]}, o[3], 0, 0, 0); } while (0)
#define FA_PVK_W(n) do { asm volatile("s_waitcnt lgkmcnt(" #n ")" ::: "memory"); FA_SBAR(); } while (0)
#define FA_PVK(VB, P0, P1) do { const int vbk_ = (VB); s16x4 Al0, Al1, Al2, Al3, Ah0, Ah1, Ah2, Ah3, Bl0, Bl1, Bl2, Bl3, Bh0, Bh1, Bh2, Bh3; bf16x8 pq0_, pq1_; \
        FA_PVK_RD(A, 0); FA_PK4(P0, 0, pq0_); FA_SBAR(); \
        FA_PVK_RD(B, 1); FA_PVK_W(8); FA_PVK_MM(A, pq0_); FA_SBAR(); FA_PK4(P0, 8, pq1_); FA_SBAR(); \
        FA_PVK_RD(A, 2); FA_PVK_W(8); FA_PVK_MM(B, pq1_); FA_SBAR(); FA_PK4(P1, 0, pq0_); FA_SBAR(); \
        FA_PVK_RD(B, 3); FA_PVK_W(8); FA_PVK_MM(A, pq0_); FA_SBAR(); FA_PK4(P1, 8, pq1_); FA_SBAR(); \
        FA_PVK_W(0); FA_PVK_MM(B, pq1_); } while (0)
#define FA_PK4(P, B_, OUT) do { unsigned a0 = cvtpk(P[B_ + 0], P[B_ + 1]), a1 = cvtpk(P[B_ + 2], P[B_ + 3]); \
        unsigned b0 = cvtpk(P[B_ + 4], P[B_ + 5]), b1 = cvtpk(P[B_ + 6], P[B_ + 7]); \
        auto r0 = __builtin_amdgcn_permlane32_swap(a0, b0, false, false); auto r1 = __builtin_amdgcn_permlane32_swap(a1, b1, false, false); \
        u32x4 w_ = {r0[0], r1[0], r0[1], r1[1]}; OUT = __builtin_bit_cast(bf16x8, w_); } while (0)
#define FA_PKB(P, S_, OUT) do { u32x4 w_ = {cvtpk(P[8 * S_ + 0], P[8 * S_ + 1]), cvtpk(P[8 * S_ + 2], P[8 * S_ + 3]), cvtpk(P[8 * S_ + 4], P[8 * S_ + 5]), cvtpk(P[8 * S_ + 6], P[8 * S_ + 7])}; OUT = __builtin_bit_cast(bf16x8, w_); } while (0)
__device__ __forceinline__ float half_bcast(float v) {
    float v2 = v; asm volatile("" : "+v"(v2)); auto rr = __builtin_amdgcn_permlane32_swap(fbits(v), fbits(v2), false, false);
    const unsigned r0_ = rr[0], r1_ = rr[1]; (void)r1_; return bitsf(r0_);
}
__device__ __forceinline__ float half_other(float v) {
    float v2 = v; asm volatile("" : "+v"(v2));
    auto rr = __builtin_amdgcn_permlane32_swap(fbits(v), fbits(v2), false, false);
    const unsigned r0_ = rr[0], r1_ = rr[1];
    return (threadIdx.x & 32) ? bitsf(r1_) : bitsf(r0_);
}
__device__ __forceinline__ float half_max(float v) { float v2 = v; asm volatile("" : "+v"(v2)); auto rr = __builtin_amdgcn_permlane32_swap(fbits(v), fbits(v2), false, false);
    const unsigned r0_ = rr[0], r1_ = rr[1]; return fmaxf(bitsf(r0_), bitsf(r1_)); }
__device__ __forceinline__ float half_add(float v) { float v2 = v; asm volatile("" : "+v"(v2)); auto rr = __builtin_amdgcn_permlane32_swap(fbits(v), fbits(v2), false, false);
    const unsigned r0_ = rr[0], r1_ = rr[1]; return bitsf(r0_) + bitsf(r1_); }

struct Stg { bf16x8 v0, v1, k0, k1; };
#define FA_SLOAD(S, Kp, Vp, kb) do { S.v0 = *(const bf16x8*)(Vp + (size_t)((kb) + sr) * 1024 + sc); S.v1 = *(const bf16x8*)(Vp + (size_t)((kb) + 32 + sr) * 1024 + sc); \
        S.k0 = *(const bf16x8*)(Kp + (size_t)((kb) + sr) * 1024 + sc); S.k1 = *(const bf16x8*)(Kp + (size_t)((kb) + 32 + sr) * 1024 + sc); } while (0)
#define FA_SWRITE(S, bf) do { *(bf16x8*)(V_lds + (bf) * SHM_V + vst0) = S.v0; *(bf16x8*)(V_lds + (bf) * SHM_V + vst1) = S.v1; \
        *(bf16x8*)(K_lds + (bf) * SHM_K + kws) = S.k0; *(bf16x8*)(K_lds + (bf) * SHM_K + kws + 32 * 256) = S.k1; } while (0)

__device__ __forceinline__ void sb_unit(const bf16_t* SBQ, const bf16_t* SBK, const bf16_t* SBV, bf16_t* MIX, const float* gain, int h, int qb, char* lds) {
    int tid_o = threadIdx.x; asm volatile("" : "+v"(tid_o));
    const int tid = tid_o, wid = __builtin_amdgcn_readfirstlane(tid >> 6), lane = tid & 63, r32 = lane & 31, hi = lane >> 5;
    char* V_lds = lds; char* K_lds = lds + 2 * SHM_V;
    const int q0 = qb * 256, qrow = q0 + wid * 32 + r32;
    const bf16_t* Kp = SBK + h * 128; const bf16_t* Vp = SBV + h * 128;
    const int sr = tid >> 4, sc = (tid & 15) * 8, vst0 = v_st(sr, sc), vst1 = v_st(32 + sr, sc), kws = FA_KSWZ(sr, sc * 2);
    const int vb0 = (int)(uintptr_t)V_lds + v_rd_base(lane);
    bf16x8 qr[8];
#pragma unroll
    for (int d0 = 0; d0 < 8; ++d0) qr[d0] = *(const bf16x8*)(SBQ + (size_t)qrow * 1024 + h * 128 + d0 * 16 + hi * 8);
    bf16x8 tpa0, tpa1, ones;
    { u32x4 t0, t1;
#pragma unroll
      for (int i = 0; i < 4; ++i) { unsigned w0 = 0, w1 = 0;
#pragma unroll
          for (int e = 0; e < 2; ++e) { const int j = 2 * i + e; const int rho0 = 8 * (j >> 2) + 4 * hi + (j & 3), rho1 = 16 + rho0;
              w0 |= (rho0 > r32 ? 0x3F80u : 0u) << (16 * e); w1 |= (rho1 > r32 ? 0x3F80u : 0u) << (16 * e); }
          t0[i] = w0; t1[i] = w1; }
      tpa0 = __builtin_bit_cast(bf16x8, t0); tpa1 = __builtin_bit_cast(bf16x8, t1);
      const u32x4 o1 = {0x3F803F80u, 0x3F803F80u, 0x3F803F80u, 0x3F803F80u}; ones = __builtin_bit_cast(bf16x8, o1); }
    f32x16 o[4];
#pragma unroll
    for (int d = 0; d < 4; ++d) o[d] = f32x16{};
    float R = 0.f;
    const int NT = 4 * qb + 4, jmax = 4 * qb + (wid >> 1);
    Stg S;
    volatile int* dfl = (volatile int*)(lds + 2 * SHM_V + 2 * SHM_K + 1024);
    bool alldone = false;
    FA_SLOAD(S, Kp, Vp, (NT - 1) * 64); FA_SWRITE(S, 0); __syncthreads();
#define FA_SB_STEP(it, BUF) do { const int j = NT - 1 - (it); \
        if ((it) + 1 < NT) FA_SLOAD(S, Kp, Vp, (j - 1) * 64); \
        if (j <= jmax) { \
            f32x16 p0, p1; qkt<0, 8>(p0, p1, K_lds + (BUF) * SHM_K, r32, hi, qr); \
            const bool msk = (j == jmax); const int dq = qrow - 64 * j - 4 * hi;       \
            bf16x8 L0a, L0b, L1a, L1b; float rfix; \
            { f32x16 lk1; \
              _Pragma("unroll") for (int r = 0; r < 16; ++r) { const int c = (r & 3) + 8 * (r >> 2); \
                const float z = __builtin_amdgcn_fmed3f(p1[r], -126.f, 126.f); const float e = __builtin_amdgcn_exp2f(-z); const float l2 = __builtin_amdgcn_logf(1.f + e); float lk = -z - l2; if (msk && !(c + 32 < dq)) lk = 0.f; lk1[r] = lk; p1[r] = R - l2; } \
              FA_PKB(lk1, 0, L1a); FA_PKB(lk1, 1, L1b); } \
            { f32x16 lk0; \
              _Pragma("unroll") for (int r = 0; r < 16; ++r) { const int c = (r & 3) + 8 * (r >> 2); \
                const float z = __builtin_amdgcn_fmed3f(p0[r], -126.f, 126.f); const float e = __builtin_amdgcn_exp2f(-z); const float l2 = __builtin_amdgcn_logf(1.f + e); float lk = -z - l2; if (msk && !(c < dq)) lk = 0.f; lk0[r] = lk; p0[r] = R - l2; } \
              rfix = lk0[0] - p0[0];                                  \
              FA_PKB(lk0, 0, L0a); FA_PKB(lk0, 1, L0b); } \
            p0 = __builtin_amdgcn_mfma_f32_32x32x16_bf16(tpa0, L0a, p0, 0, 0, 0); p0 = __builtin_amdgcn_mfma_f32_32x32x16_bf16(tpa1, L0b, p0, 0, 0, 0); \
            p0 = __builtin_amdgcn_mfma_f32_32x32x16_bf16(ones, L1a, p0, 0, 0, 0); p0 = __builtin_amdgcn_mfma_f32_32x32x16_bf16(ones, L1b, p0, 0, 0, 0); \
            p1 = __builtin_amdgcn_mfma_f32_32x32x16_bf16(tpa0, L1a, p1, 0, 0, 0); p1 = __builtin_amdgcn_mfma_f32_32x32x16_bf16(tpa1, L1b, p1, 0, 0, 0); \
            const float rn = p0[0] + rfix + R;                        \
            _Pragma("unroll") for (int r = 0; r < 16; ++r) { const int c = (r & 3) + 8 * (r >> 2); \
                float w0 = __builtin_amdgcn_exp2f(p0[r]); if (msk && !(c < dq)) w0 = 0.f; p0[r] = w0; \
                float w1 = __builtin_amdgcn_exp2f(p1[r]); if (msk && !(c + 32 < dq)) w1 = 0.f; p1[r] = w1; } \
            R = half_bcast(rn); \
            bf16x8 pa0, pa1, pa2, pa3; FA_PK4(p0, 0, pa0); FA_PK4(p0, 8, pa1); FA_PK4(p1, 0, pa2); FA_PK4(p1, 8, pa3); \
            pv_tile(o, vb0 + (BUF) * SHM_V, pa0, pa1, pa2, pa3); \
        } \
        { const bool wdone = (j <= jmax) && __all(R < SB_STOP); if (lane == 0) dfl[(BUF) * 8 + wid] = wdone ? 1 : 0; } \
        if ((it) + 1 < NT) FA_SWRITE(S, (BUF) ^ 1); \
        __syncthreads(); \
        { int c_ = 0; _Pragma("unroll") for (int w_ = 0; w_ < 8; ++w_) c_ += dfl[(BUF) * 8 + w_]; alldone = (c_ == 8); } } while (0)
#pragma unroll 1
    for (int it = 0; it < NT; it += 2) { FA_SB_STEP(it, 0); if (alldone) break; FA_SB_STEP(it + 1, 1); if (alldone) break; }
#undef FA_SB_STEP
    float ss[16];
#pragma unroll
    for (int r = 0; r < 16; ++r) { float v = o[0][r] * o[0][r] + o[1][r] * o[1][r] + o[2][r] * o[2][r] + o[3][r] * o[3][r];
        v = half32_sum(v);
        ss[r] = 1.f / sqrtf(v * (1.f / 128.f) + RMS_EPS); }
    float gn[4];
#pragma unroll
    for (int d0 = 0; d0 < 4; ++d0) gn[d0] = gain[h * 128 + d0 * 32 + r32];
    bf16_t* Ow = MIX + (size_t)(q0 + wid * 32) * DM + h * 128;
#pragma unroll
    for (int r = 0; r < 16; ++r) { const int orow = crow(r, hi);
#pragma unroll
        for (int d0 = 0; d0 < 4; ++d0) { const float v = o[d0][r] * ss[r] * gn[d0]; const float vn = dpp_xor1(v);
            if ((r32 & 1) == 0) *(unsigned*)(Ow + (size_t)orow * DM + d0 * 32 + r32) = cvtpk(v, vn); } }
    __syncthreads();
}

__device__ __forceinline__ void df_unit(const bf16_t* DQ, const bf16_t* DK, const bf16_t* DV, bf16_t* MIX, const float* gain, float lam, int h, int qb, char* lds) {
    int tid_o = threadIdx.x; asm volatile("" : "+v"(tid_o));
    const int tid = tid_o, wid = __builtin_amdgcn_readfirstlane(tid >> 6), lane = tid & 63, r32 = lane & 31, hi = lane >> 5;
    const int mp = wid >> 2, qw = wid & 3;
    char* V_lds = lds; char* K_lds = lds + 2 * SHM_V;
    float* wsf = (float*)(lds + 2 * SHM_V + 2 * SHM_K) + wid * 64; float* li_l = wsf; float* al_l = wsf + 32;
    const int q0 = qb * 128, qrow = q0 + qw * 32 + r32;
    const bf16_t* Kp = DK + h * 128; const bf16_t* Vp = DV + h * 128;
    const int sr = tid >> 4, sc = (tid & 15) * 8, vst0 = v_st(sr, sc), vst1 = v_st(32 + sr, sc), kws = FA_KSWZ(sr, sc * 2);
    const int vb0 = (int)(uintptr_t)V_lds + v_rd_base(lane);
    const int NT = 2 * qb + 2, jmax = 2 * qb + (qw >> 1);
    bf16x8 qr[4];
#pragma unroll
    for (int d0 = 0; d0 < 4; ++d0) qr[d0] = *(const bf16x8*)(DQ + (size_t)qrow * 1024 + h * 128 + mp * 64 + d0 * 16 + hi * 8);
    f32x16 o[4];
#pragma unroll
    for (int d = 0; d < 4; ++d) o[d] = f32x16{};
    float m_reg = -1e30f, l_reg = 0.f;
    Stg S0;
    f32x16 pA0, pA1, pB0, pB1; float alA = 1.f, alB = 1.f;
    const int kq = mp * 128;
#define DF_QKT(P0, P1, BUF) do { const char* Kb_ = K_lds + (BUF) * SHM_K; P0 = f32x16{}; P1 = f32x16{}; \
        _Pragma("unroll") for (int d = 0; d < 4; ++d) { const int cb = kq + (d * 16 + hi * 8) * 2; \
            const bf16x8 b0 = *reinterpret_cast<const bf16x8*>(Kb_ + FA_KSWZ(r32, cb)); const bf16x8 b1 = *reinterpret_cast<const bf16x8*>(Kb_ + FA_KSWZ(32 + r32, cb)); \
            P0 = __builtin_amdgcn_mfma_f32_32x32x16_bf16(b0, qr[d], P0, 0, 0, 0); P1 = __builtin_amdgcn_mfma_f32_32x32x16_bf16(b1, qr[d], P1, 0, 0, 0); } } while (0)
#define DF_PSM(P0, P1, AL) do { \
        float pmax = P0[0]; \
        _Pragma("unroll") for (int r = 1; r < 16; ++r) pmax = fmaxf(pmax, P0[r]); \
        _Pragma("unroll") for (int r = 0; r < 16; ++r) pmax = fmaxf(pmax, P1[r]); \
        pmax = half_max(pmax); float mn; \
        if (__all(pmax - m_reg <= 8.f)) { mn = m_reg; AL = 1.f; } else { mn = fmaxf(m_reg, pmax); AL = __builtin_amdgcn_exp2f(m_reg - mn); m_reg = mn; } \
        _Pragma("unroll") for (int r = 0; r < 16; ++r) { P0[r] -= mn; P1[r] -= mn; } \
        _Pragma("unroll") for (int r = 0; r < 16; ++r) P0[r] = __builtin_amdgcn_exp2f(P0[r]); } while (0)
#define DF_MASK(P0, P1, J) do { const int dq = qrow - 64 * (J) - 4 * hi; const float NEG = -__builtin_inff(); \
        _Pragma("unroll") for (int r = 0; r < 16; ++r) { const int c = (r & 3) + 8 * (r >> 2); if (c > dq) P0[r] = NEG; if (c + 32 > dq) P1[r] = NEG; } } while (0)
#define DF_FSM(P0, P1, AL) do { \
        _Pragma("unroll") for (int r = 0; r < 16; ++r) P1[r] = __builtin_amdgcn_exp2f(P1[r]); \
        float ps = 0.f; \
        _Pragma("unroll") for (int r = 0; r < 16; ++r) ps += P0[r]; \
        _Pragma("unroll") for (int r = 0; r < 16; ++r) ps += P1[r]; \
        ps = half_add(ps); l_reg = l_reg * (AL) + ps; } while (0)
#define DF_RESC(AL) do { if (__any((AL) < 1.f)) { if (hi == 0) al_l[r32] = (AL); asm volatile("s_waitcnt lgkmcnt(0)" ::: "memory"); \
        _Pragma("unroll") for (int r = 0; r < 16; ++r) { const float al = al_l[crow(r, hi)]; o[0][r] *= al; o[1][r] *= al; o[2][r] *= al; o[3][r] *= al; } } } while (0)
#define DF_PV_PSM(VB, Y0, Y1, X0, X1, AL) do { const int vbk_ = (VB); s16x4 Al0, Al1, Al2, Al3, Ah0, Ah1, Ah2, Ah3, Bl0, Bl1, Bl2, Bl3, Bh0, Bh1, Bh2, Bh3; bf16x8 pq0_, pq1_; float pmax_, mn_; \
        FA_PVK_RD(A, 0); FA_PK4(Y0, 0, pq0_); FA_SBAR(); \
        FA_PVK_RD(B, 1); FA_PVK_W(8); FA_PVK_MM(A, pq0_); \
        pmax_ = X0[0]; _Pragma("unroll") for (int r = 1; r < 16; ++r) pmax_ = fmaxf(pmax_, X0[r]); \
        FA_PK4(Y0, 8, pq1_); FA_SBAR(); \
        FA_PVK_RD(A, 2); FA_PVK_W(8); FA_PVK_MM(B, pq1_); \
        _Pragma("unroll") for (int r = 0; r < 16; ++r) pmax_ = fmaxf(pmax_, X1[r]); \
        pmax_ = half_max(pmax_); \
        { const bool ok_ = __all(pmax_ - m_reg <= 8.f); mn_ = ok_ ? m_reg : fmaxf(m_reg, pmax_); AL = __builtin_amdgcn_exp2f(m_reg - mn_); m_reg = mn_; } \
        FA_PK4(Y1, 0, pq0_); FA_SBAR(); \
        FA_PVK_RD(B, 3); FA_PVK_W(8); FA_PVK_MM(A, pq0_); \
        _Pragma("unroll") for (int r = 0; r < 16; ++r) { X0[r] -= mn_; X1[r] -= mn_; } \
        FA_PK4(Y1, 8, pq1_); FA_SBAR(); \
        FA_PVK_W(0); FA_PVK_MM(B, pq1_); \
        _Pragma("unroll") for (int r = 0; r < 16; ++r) X0[r] = __builtin_amdgcn_exp2f(X0[r]); } while (0)
#define DF_STEP_U(J, X0, X1, ALX, Y0, Y1, ALY, BX, SLD, SWR) do { \
        FA_SBAR(); DF_QKT(X0, X1, BX); DF_FSM(Y0, Y1, ALY); FA_SBAR(); \
        FA_SLOAD(S0, Kp, Vp, ((J) + 1) * 64); FA_SBAR(); \
        DF_PV_PSM(vb0 + ((BX) ^ 1) * SHM_V, Y0, Y1, X0, X1, ALX); \
        __syncthreads(); FA_SWRITE(S0, (BX) ^ 1); \
        DF_RESC(ALX); __syncthreads(); } while (0)
#define DF_STEP_G(J, X0, X1, ALX, Y0, Y1, ALY, BX, SLD, SWR) do { const int j_ = (J); const bool hx = j_ < NT && j_ <= jmax, hy = j_ >= 1 && j_ - 1 <= jmax; \
        FA_SBAR(); if (hx) DF_QKT(X0, X1, BX); if (hy) DF_FSM(Y0, Y1, ALY); FA_SBAR(); \
        if (j_ + 1 < NT) FA_SLOAD(S0, Kp, Vp, (j_ + 1) * 64); FA_SBAR(); \
        if (hy) FA_PVK(vb0 + ((BX) ^ 1) * SHM_V, Y0, Y1); \
        ALX = 1.f; if (hx) { if (j_ == jmax) DF_MASK(X0, X1, j_); DF_PSM(X0, X1, ALX); } \
        __syncthreads(); if (j_ + 1 < NT) FA_SWRITE(S0, (BX) ^ 1); \
        DF_RESC(ALX); __syncthreads(); } while (0)
    FA_SLOAD(S0, Kp, Vp, 0); FA_SWRITE(S0, 0); __syncthreads();
    DF_STEP_G(0, pA0, pA1, alA, pB0, pB1, alB, 0, S0, S1);
    int j = 1;
#pragma unroll 1
    for (; j + 1 <= NT - 3; j += 2) {
        DF_STEP_U(j, pB0, pB1, alB, pA0, pA1, alA, 1, S1, S0);
        DF_STEP_U(j + 1, pA0, pA1, alA, pB0, pB1, alB, 0, S0, S1);
    }
#pragma unroll 1
    for (; j <= NT; j += 2) {
        DF_STEP_G(j, pB0, pB1, alB, pA0, pA1, alA, 1, S1, S0);
        if (j + 1 <= NT) DF_STEP_G(j + 1, pA0, pA1, alA, pB0, pB1, alB, 0, S0, S1);
    }
#undef DF_QKT
#undef DF_PSM
#undef DF_MASK
#undef DF_FSM
#undef DF_RESC
#undef DF_STEP_U
#undef DF_PV_PSM
#undef DF_STEP_G
    if (hi == 0) li_l[r32] = l_reg; asm volatile("s_waitcnt lgkmcnt(0)" ::: "memory");
#pragma unroll
    for (int r = 0; r < 16; ++r) { const float il = 1.f / li_l[crow(r, hi)]; o[0][r] *= il; o[1][r] *= il; o[2][r] *= il; o[3][r] *= il; }
    float* ex = (float*)lds + qw * 4096 + lane;
    if (mp == 1) {
#pragma unroll
        for (int d = 0; d < 4; ++d)
#pragma unroll
            for (int r = 0; r < 16; ++r) ex[(d * 16 + r) * 64] = o[d][r];
    }
    __syncthreads();
    if (mp == 0) {
#pragma unroll
        for (int d = 0; d < 4; ++d)
#pragma unroll
            for (int r = 0; r < 16; ++r) o[d][r] -= lam * ex[(d * 16 + r) * 64];
        float ss[16];
#pragma unroll
        for (int r = 0; r < 16; ++r) { float v = o[0][r] * o[0][r] + o[1][r] * o[1][r] + o[2][r] * o[2][r] + o[3][r] * o[3][r];
            v = half32_sum(v);
            ss[r] = (1.f - LAMBDA_INIT) / sqrtf(v * (1.f / 128.f) + RMS_EPS); }
        float gn[4];
#pragma unroll
        for (int d0 = 0; d0 < 4; ++d0) gn[d0] = gain[d0 * 32 + r32];
        bf16_t* Ow = MIX + (size_t)(q0 + qw * 32) * DM + 1024 + h * 128;
#pragma unroll
        for (int r = 0; r < 16; ++r) { const int orow = crow(r, hi);
#pragma unroll
            for (int d0 = 0; d0 < 4; ++d0) { const float v = o[d0][r] * ss[r] * gn[d0]; const float vn = dpp_xor1(v);
                if ((r32 & 1) == 0) *(unsigned*)(Ow + (size_t)orow * DM + d0 * 32 + r32) = cvtpk(v, vn); } }
    }
    __syncthreads();
}
#undef FA_SLOAD
#undef FA_SWRITE
}

#ifndef REP_DF
#define REP_DF 1
#endif
#ifndef REP_SB
#define REP_SB 1
#endif
__device__ __forceinline__ void attn_fast_phase(const Args& a, LAS unsigned char* lds_las, bf16_t* MIXo, int blk, int G) {
    unsigned char* ws = a.ws; char* lds = (char*)lds_las;
    const bf16_t* proj = (const bf16_t*)(ws + WS_PROJ);
    const float lam = ((const float*)(ws + WS_CTL))[CW_LAM];
    for (int item = blk; item < 256; item += G) {
        const int h = item & 7, p = item >> 3;
#pragma unroll 1
        for (int pass = 0; pass < 2 * REP_DF; ++pass) fa::df_unit(proj + 3 * PROJ_SEC, proj + 4 * PROJ_SEC, proj + 5 * PROJ_SEC, MIXo, a.in[5], lam, h, (pass & 1) == 0 ? 63 - p : p, lds);
#pragma unroll 1
        for (int rep = 0; rep < REP_SB; ++rep)
        fa::sb_unit(proj, proj + PROJ_SEC, proj + 2 * PROJ_SEC, MIXo, a.in[3], h, p, lds);
    }
}

__device__ __forceinline__ void xattn_naive_phase(const Args& a, LAS unsigned char* lds, int gw, int NGW, int wave, int lane) {
    unsigned char* ws = a.ws;
    const bf16_t* QM = (const bf16_t*)(ws + WS_QM); const bf16_t* KM = (const bf16_t*)(ws + WS_KM); const bf16_t* VMT = (const bf16_t*)(ws + WS_VMT);
    bf16_t* OM = (bf16_t*)(ws + WS_OM);
    LAS float* qs = (LAS float*)(lds + wave * 4096);
    LAS float* ps = (LAS float*)(lds + wave * 4096 + 2048);
    for (int it = gw; it < SEQ * 4; it += NGW) {
        const int t = it >> 2, h = it & 3;
        { const u32x4 w = *(const u32x4*)(QM + (size_t)t * DM + h * 512 + 8 * lane); LAS float* q = qs + 8 * lane;
          q[0] = bflo(w.x); q[1] = bfhi(w.x); q[2] = bflo(w.y); q[3] = bfhi(w.y); q[4] = bflo(w.z); q[5] = bfhi(w.z); q[6] = bflo(w.w); q[7] = bfhi(w.w); }
        LDS_WAIT();
        float sc[4]; float mx = -1e30f;
        for (int i = 0; i < 4; ++i) { const int key = lane + 64 * i; const u32x4* kp = (const u32x4*)(KM + (size_t)key * DM + h * 512); float z = 0.f;
            for (int d = 0; d < 64; ++d) { const u32x4 kw = kp[d]; const LAS float* q8 = qs + 8 * d;
                z += bflo(kw.x) * q8[0] + bfhi(kw.x) * q8[1] + bflo(kw.y) * q8[2] + bfhi(kw.y) * q8[3] + bflo(kw.z) * q8[4] + bfhi(kw.z) * q8[5] + bflo(kw.w) * q8[6] + bfhi(kw.w) * q8[7]; }
            sc[i] = z; mx = fmaxf(mx, z); }
        mx = wave_max(mx); float sum = 0.f;
        for (int i = 0; i < 4; ++i) { sc[i] = __builtin_amdgcn_exp2f(sc[i] - mx); sum += sc[i]; }
        sum = wave_sum(sum); const float inv = 1.f / sum;
        for (int i = 0; i < 4; ++i) ps[lane + 64 * i] = sc[i] * inv;
        LDS_WAIT();
        float acc[8];
        for (int e = 0; e < 8; ++e) { const u32x4* vp = (const u32x4*)(VMT + (size_t)(h * 512 + 8 * lane + e) * MEM); float s = 0.f;
            for (int k8 = 0; k8 < 32; ++k8) { const u32x4 vw = vp[k8]; const LAS float* p8 = ps + 8 * k8;
                s += bflo(vw.x) * p8[0] + bfhi(vw.x) * p8[1] + bflo(vw.y) * p8[2] + bfhi(vw.y) * p8[3] + bflo(vw.z) * p8[4] + bfhi(vw.z) * p8[5] + bflo(vw.w) * p8[6] + bfhi(vw.w) * p8[7]; }
            acc[e] = s; }
        *(u32x4*)(OM + (size_t)t * DM + h * 512 + 8 * lane) = (u32x4){pk2(acc[0], acc[1]), pk2(acc[2], acc[3]), pk2(acc[4], acc[5]), pk2(acc[6], acc[7])};
        LDS_WAIT();
    }
}


__device__ __forceinline__ void xattn_fast_phase(const Args& a, LAS unsigned char* lds, int gw, int NGW, int lane) {
    unsigned char* ws = a.ws;
    const bf16_t* QM = (const bf16_t*)(ws + WS_QM); const bf16_t* KM = (const bf16_t*)(ws + WS_KM); const bf16_t* VMT = (const bf16_t*)(ws + WS_VMT);
    bf16_t* PB = (bf16_t*)(ws + WS_OM);
    const int r32 = lane & 31, hi = lane >> 5;
    const int blk_ = gw >> 3, wv_ = gw & 7, nblk_ = NGW >> 3;
#define XA_BAR() do { __builtin_amdgcn_sched_barrier(0); asm volatile("s_waitcnt lgkmcnt(0)\n\ts_barrier" ::: "memory"); __builtin_amdgcn_sched_barrier(0); } while (0)
#pragma unroll 1
    for (int ub = blk_; ub < 256; ub += nblk_) {
        const int h = ub & 3;
        if (wv_ >= 4) {
            const int tl = (wv_ - 4) * 64 + lane;
            u32x4 R[8];
            { const u32x4* src = (const u32x4*)(KM + (size_t)h * 131072) + tl;
#pragma unroll
              for (int i = 0; i < 8; ++i) R[i] = src[i * 256]; }
#pragma unroll 1
            for (int c = 0; c < 8; ++c) {
                LAS u32x4* dst = (LAS u32x4*)(lds + (c & 1) * 32768) + tl;
#pragma unroll
                for (int i = 0; i < 8; ++i) dst[i * 256] = R[i];
                if (c + 1 < 8) { const int cn = c + 1; const u32x4* src = (const u32x4*)(KM + (size_t)h * 131072 + (size_t)cn * 16384) + tl;
#pragma unroll
                    for (int i = 0; i < 8; ++i) R[i] = src[i * 256]; }
                XA_BAR();
            }
            continue;
        }
        const int qb = (ub >> 2) * 4 + wv_;
        f32x16 s[8];
#pragma unroll
        for (int t = 0; t < 8; ++t) s[t] = f32x16{};
        const bf16_t* qp = QM + (size_t)(qb * 32 + r32) * DM + h * 512 + 8 * hi;
        bf16x8 qn[4];
#pragma unroll
        for (int kk = 0; kk < 4; ++kk) qn[kk] = *(const bf16x8*)(qp + 16 * kk);
#pragma unroll 1
        for (int c = 0; c < 8; ++c) {
            bf16x8 qc[4];
#pragma unroll
            for (int kk = 0; kk < 4; ++kk) qc[kk] = qn[kk];
            if (c + 1 < 8) {
#pragma unroll
                for (int kk = 0; kk < 4; ++kk) qn[kk] = *(const bf16x8*)(qp + 16 * (4 * (c + 1) + kk)); }
            XA_BAR();
            const LAS bf16x8* kf = (const LAS bf16x8*)(lds + (c & 1) * 32768) + lane;
#pragma unroll
            for (int kk = 0; kk < 4; ++kk)
#pragma unroll
                for (int t = 0; t < 8; ++t) { const bf16x8 ak = kf[(kk * 8 + t) * 64]; s[t] = __builtin_amdgcn_mfma_f32_32x32x16_bf16(ak, qc[kk], s[t], 0, 0, 0); }
        }
        float mx = -1e30f;
#pragma unroll
        for (int t = 0; t < 8; ++t)
#pragma unroll
            for (int r = 0; r < 16; ++r) mx = fmaxf(mx, s[t][r]);
        mx = fmaxf(mx, __shfl_xor(mx, 32));
        float sum = 0.f;
#pragma unroll
        for (int t = 0; t < 8; ++t)
#pragma unroll
            for (int r = 0; r < 16; ++r) { const float e = __builtin_amdgcn_exp2f(s[t][r] - mx); s[t][r] = e; sum += e; }
        sum += __shfl_xor(sum, 32);
        const float inv = 1.f / sum;
        bf16x8 pa[16];
#pragma unroll
        for (int t = 0; t < 8; ++t) {
#pragma unroll
            for (int r = 0; r < 16; ++r) s[t][r] *= inv;
            FA_PK4(s[t], 0, pa[2 * t]); FA_PK4(s[t], 8, pa[2 * t + 1]); }
        { bf16_t* Pw = PB + (size_t)(qb * 32 + r32) * 1024 + h * 256 + 8 * hi;
#pragma unroll
          for (int ks = 0; ks < 16; ++ks) *(bf16x8*)(Pw + 16 * ks) = pa[ks]; }
    }
#undef XA_BAR
}
__device__ __forceinline__ float erf_f32(float z) {
    const float ax = fabsf(z), t = __builtin_amdgcn_rcpf(1.f + 0.3275911f * ax);
    const float poly = ((((1.061405429f * t - 1.453152027f) * t + 1.421413741f) * t - 0.284496736f) * t + 0.254829592f) * t;
    const float r = 1.f - poly * __builtin_amdgcn_exp2f(-ax * ax * LOG2E);
    return __builtin_copysignf(r, z);
}
__device__ __forceinline__ float max3f(float a, float b, float c) { return fmaxf(fmaxf(a, b), c); }
__device__ __forceinline__ void cex_desc(float& a, float& b) { const float mx = fmaxf(a, b), mn = fminf(a, b); a = mx; b = mn; }
__device__ __forceinline__ void sort16_desc(float* v) {
#pragma unroll
    for (int k = 2; k <= 16; k <<= 1)
#pragma unroll
        for (int j = k >> 1; j > 0; j >>= 1)
#pragma unroll
            for (int i = 0; i < 16; ++i) { const int l = i ^ j; if (l > i) { if ((i & k) == 0) cex_desc(v[i], v[l]); else cex_desc(v[l], v[i]); } }
}
__device__ __forceinline__ void merge_top16(float* a, const float* b) {
#pragma unroll
    for (int i = 0; i < 16; ++i) a[i] = fmaxf(a[i], b[15 - i]);
#pragma unroll
    for (int j = 8; j > 0; j >>= 1)
#pragma unroll
        for (int i = 0; i < 16; ++i) { const int l = i ^ j; if (l > i) cex_desc(a[i], a[l]); }
}

__device__ __forceinline__ int fresh_lane() { unsigned m_ = ~0u; asm volatile("" : "+s"(m_));
    int l_ = (int)__builtin_amdgcn_mbcnt_hi(m_, __builtin_amdgcn_mbcnt_lo(m_, 0u)); asm volatile("" : "+v"(l_)); return l_; }
__device__ __forceinline__ void peer_phase(const Args& a, LAS unsigned char* lds, int blk, int nblk, int wave, int lane) {
    unsigned char* ws = a.ws;
    const bf16_t* QP = (const bf16_t*)(ws + WS_QP); const bf16_t* KEYS = (const bf16_t*)(ws + WS_KEYS); const bf16_t* X2 = (const bf16_t*)(ws + WS_Y);
    const unsigned char* UT = ws + WS_UT; const unsigned char* VT = ws + WS_VT;
    constexpr int PEER_WLDS = 8192 + 256 + 4096;
    LAS int* idxs = (LAS int*)(lds + wave * PEER_WLDS);
    LAS float* gts = (LAS float*)(lds + wave * PEER_WLDS + 2048);
    LAS float* tops = (LAS float*)(lds + wave * PEER_WLDS + 4096);
    const float NEG = -__builtin_inff();
    LAS f32x4* gb = (LAS f32x4*)(lds + NWAVES * PEER_WLDS);
    { const int tid_ = wave * 64 + lane; gb[tid_] = ((const f32x4*)a.in[12])[tid_]; gb[512 + tid_] = ((const f32x4*)a.in[13])[tid_]; gb[1024 + tid_] = ((const f32x4*)a.in[18])[tid_]; gb[1536 + tid_] = ((const f32x4*)a.in[19])[tid_]; }
    __syncthreads();
    for (int tb = blk; tb < SEQ / 32; tb += nblk) {
        const int t0 = tb * 32 + wave * 4;
        int lane_o = fresh_lane(); asm volatile("" : "+v"(lane_o));
        const int row = lane_o & 31, hi = lane_o >> 5, tl_r = row >> 3, h_r = row & 7;
#ifndef PEER_PARTS
#define PEER_PARTS 7
#endif
        if (PEER_PARTS & 1)
#pragma unroll 1
        for (int c = 0; c < 2; ++c) {
            f32x16 s[4];
#pragma unroll
            for (int nt = 0; nt < 4; ++nt) s[nt] = f32x16{};
            const bf16_t* qp = QP + (size_t)(t0 + tl_r) * DM + h_r * 256 + c * 128 + 8 * hi;
            const bf16_t* kp = KEYS + (size_t)c * 128 * 128 + (size_t)row * 128 + 8 * hi;
            bf16x8 qA[2], kA[2][4], qB[2], kB[2][4];
#define PEER_SLD(Q, K, w) do { _Pragma("unroll") for (int j = 0; j < 2; ++j) { const int ks = 2 * (w) + j; Q[j] = *(const bf16x8*)(qp + 16 * ks); \
                _Pragma("unroll") for (int nt = 0; nt < 4; ++nt) K[j][nt] = *(const bf16x8*)(kp + (size_t)nt * 32 * 128 + 16 * ks); } } while (0)
#define PEER_SMM(Q, K) do { _Pragma("unroll") for (int j = 0; j < 2; ++j) _Pragma("unroll") for (int nt = 0; nt < 4; ++nt) s[nt] = __builtin_amdgcn_mfma_f32_32x32x16_bf16(K[j][nt], Q[j], s[nt], 0, 0, 0); } while (0)
#define PEER_SB() __builtin_amdgcn_sched_barrier(0)
            PEER_SLD(qA, kA, 0); PEER_SLD(qB, kB, 1); PEER_SB();
            PEER_SMM(qA, kA); PEER_SB(); PEER_SLD(qA, kA, 2); PEER_SB();
            PEER_SMM(qB, kB); PEER_SB(); PEER_SLD(qB, kB, 3); PEER_SB();
            PEER_SMM(qA, kA); PEER_SB();
            PEER_SMM(qB, kB); PEER_SB();
#undef PEER_SLD
#undef PEER_SMM
#undef PEER_SB
#if defined(PEER_DBG_CMP)
            { float* dbg = (float*)(ws + WS_Y) + (size_t)(blk * NWAVES + wave) * 8192 + c * 4096;
              _Pragma("unroll") for (int nt = 0; nt < 4; ++nt) _Pragma("unroll") for (int r = 0; r < 16; ++r) dbg[(32 * nt + crow(r, hi)) * 32 + row] = s[nt][r]; }
#endif
            float sp[64];
#pragma unroll
            for (int nt = 0; nt < 4; ++nt)
#pragma unroll
                for (int r = 0; r < 16; ++r) { const float sv_ = s[nt][r]; const unsigned ub = (fbits(sv_) & ~127u) | (unsigned)(32 * nt + crow(r, hi)); sp[nt * 16 + r] = bitsf(ub); }
            sort16_desc(sp); sort16_desc(sp + 16); sort16_desc(sp + 32); sort16_desc(sp + 48);
            merge_top16(sp, sp + 16); merge_top16(sp + 32, sp + 48); merge_top16(sp, sp + 32);
            float Lo[16], Hi[16];
#pragma unroll
            for (int i = 0; i < 16; ++i) { float m2 = sp[i]; asm volatile("" : "+v"(m2));
                auto rr = __builtin_amdgcn_permlane32_swap(fbits(sp[i]), fbits(m2), false, false);
                const unsigned r0_ = rr[0], r1_ = rr[1]; Lo[i] = bitsf(r0_); Hi[i] = bitsf(r1_); }
            merge_top16(Lo, Hi);
            if (hi == 0) {
#pragma unroll
                for (int k = 0; k < 16; ++k) tops[(c * 16 + k) * 32 + row] = Lo[k]; }
        }
        LDS_WAIT();
        if (PEER_PARTS & 2) {
            int lane_s = fresh_lane(); asm volatile("" : "+v"(lane_s));
            const int row = lane_s & 31, hi = lane_s >> 5, tl_r = row >> 3, h_r = row & 7;
            float v1[16], v2[16];
#pragma unroll
            for (int k = 0; k < 16; ++k) { v1[k] = tops[k * 32 + row]; v2[k] = tops[(16 + k) * 32 + row]; }
            float cv[64];
            { int n = 0;
#pragma unroll
              for (int aa = 0; aa < 16; ++aa)
#pragma unroll
                  for (int bb = 0; bb < 16; ++bb) if ((aa + 1) * (bb + 1) <= 16) {
                      const float sum = v1[aa] + v2[bb];
                      cv[n] = bitsf((fbits(sum) & ~255u) | (unsigned)(aa << 4 | bb));
                      ++n; }
#pragma unroll
              for (int i = 50; i < 64; ++i) cv[i] = NEG; }
            sort16_desc(cv); sort16_desc(cv + 16); sort16_desc(cv + 32); sort16_desc(cv + 48);
            merge_top16(cv, cv + 16); merge_top16(cv + 32, cv + 48); merge_top16(cv, cv + 32);
            float topv[16];
#pragma unroll
            for (int k = 0; k < 16; ++k) { topv[k] = cv[k];
                const unsigned tg = fbits(cv[k]) & 255u; const int aa = (int)(tg >> 4), bb = (int)(tg & 15u);
                const unsigned i1 = fbits(tops[aa * 32 + row]) & 127u, i2 = fbits(tops[(16 + bb) * 32 + row]) & 127u;
                if (hi == 0) idxs[tl_r * 128 + h_r * 16 + k] = (int)((i1 << 7) | i2); }
            float sum = 0.f; const float top0 = topv[0];
#pragma unroll
            for (int k = 0; k < 16; ++k) { topv[k] = __builtin_amdgcn_exp2f((topv[k] - top0) * LOG2E); sum += topv[k]; }
            const float inv = 1.f / sum;
            if (hi == 0) {
#pragma unroll
                for (int k = 0; k < 16; ++k) gts[tl_r * 128 + h_r * 16 + k] = topv[k] * inv;
            }
        }
        LDS_WAIT();
#if defined(PEER_DBG_CMP)
        LAS int* idxs_f = (LAS int*)(lds + 70000 + wave * 8192);
        LAS float* gts_f = (LAS float*)(lds + 70000 + wave * 8192 + 2048);
        LAS float* tops_f = (LAS float*)(lds + 70000 + wave * 8192 + 4096);
        for (int i = lane; i < 512; i += 64) { idxs_f[i] = idxs[i]; gts_f[i] = gts[i]; }
        for (int i = lane; i < 1024; i += 64) tops_f[i] = tops[i];
        LDS_WAIT();
        int mm1 = 0, mm2 = 0, mmg = 0, mm3 = 0; VM_WAIT();
#endif
#if defined(PEER_SLOW_SELECT)
        {
            LAS float* vs = tops;
            LAS int* is = (LAS int*)(tops + 64);
            _Pragma("unroll 1") for (int rr = 0; rr < 32; ++rr) {
                const int t = t0 + (rr >> 3), h = rr & 7;
                _Pragma("unroll 1") for (int c = 0; c < 2; ++c) {
                    float v0 = 0.f, v1 = 0.f;
                    const bf16_t* qrow = QP + (size_t)t * DM + h * 256 + c * 128;
                    const float* k0 = a.in[15] + (size_t)c * 128 * 128 + (size_t)lane * 128; const float* k1 = k0 + 64 * 128;
                    _Pragma("unroll 1") for (int d = 0; d < 128; ++d) { const float q = bf1(qrow[d]); v0 += q * k0[d]; v1 += q * k1[d]; }
#if defined(PEER_DBG_CMP)
                    { const float* dbg = (const float*)(ws + WS_Y) + (size_t)(blk * NWAVES + wave) * 8192 + c * 4096;
                      if (fabsf(dbg[lane * 32 + rr] - v0) > 0.05f) ++mm3; if (fabsf(dbg[(lane + 64) * 32 + rr] - v1) > 0.05f) ++mm3; }
#endif
                    _Pragma("unroll 1") for (int k = 0; k < 16; ++k) {
                        const float m = wave_max(fmaxf(v0, v1));
                        const bool i0 = v0 == m, i1 = v1 == m;
                        const unsigned long long bal = __ballot(i0 || i1);
                        const int src = __ffsll((long long)bal) - 1;
                        const int myidx = i0 ? lane : lane + 64;
                        const int idx = __shfl(myidx, src);
                        if (lane == src) { if (i0) v0 = NEG; else v1 = NEG; }
                        if (lane == 0) { vs[c * 16 + k] = m; is[c * 16 + k] = idx; }
                    }
                }
                LDS_WAIT();
#if defined(PEER_DBG_CMP)
                if (lane < 32) { const int c_ = lane >> 4, k_ = lane & 15; const int fi = (int)(__builtin_bit_cast(unsigned, tops_f[(c_ * 16 + k_) * 32 + rr]) & 127u); if (fi != is[c_ * 16 + k_]) ++mm1; }
#endif
                float cvv[4]; int cii[4];
                _Pragma("unroll") for (int i = 0; i < 4; ++i) { const int j = lane + 64 * i, aa = j >> 4, bb = j & 15; cvv[i] = vs[aa] + vs[16 + bb]; cii[i] = is[aa] * 128 + is[16 + bb]; }
                float tv[16];
                _Pragma("unroll") for (int k = 0; k < 16; ++k) {
                    const float m = wave_max(fmaxf(fmaxf(cvv[0], cvv[1]), fmaxf(cvv[2], cvv[3])));
                    const bool e0 = cvv[0] == m, e1 = cvv[1] == m, e2 = cvv[2] == m, e3 = cvv[3] == m;
                    const unsigned long long bal = __ballot(e0 || e1 || e2 || e3);
                    const int src = __ffsll((long long)bal) - 1;
                    const int myidx = e0 ? cii[0] : (e1 ? cii[1] : (e2 ? cii[2] : cii[3]));
                    const int idx = __shfl(myidx, src);
                    if (lane == src) { if (e0) cvv[0] = NEG; else if (e1) cvv[1] = NEG; else if (e2) cvv[2] = NEG; else cvv[3] = NEG; }
                    tv[k] = m;
                    if (lane == 0) idxs[rr * 16 + k] = idx;
                }
                float sum = 0.f;
                const float tv0 = tv[0]; _Pragma("unroll") for (int k = 0; k < 16; ++k) { tv[k] = __builtin_amdgcn_exp2f((tv[k] - tv0) * LOG2E); sum += tv[k]; }
                if (lane == 0) { _Pragma("unroll") for (int k = 0; k < 16; ++k) gts[rr * 16 + k] = tv[k] / sum; }
                LDS_WAIT();
#if defined(PEER_DBG_CMP)
                if (lane < 16) { if (idxs_f[rr * 16 + lane] != idxs[rr * 16 + lane]) ++mm2; if (fabsf(gts_f[rr * 16 + lane] - gts[rr * 16 + lane]) > 2e-3f) ++mmg; }
#endif
            }
        }
#endif
#if defined(PEER_DBG_CMP)
        { const int s1_ = (int)wave_sum((float)mm1), s2_ = (int)wave_sum((float)mm2), sg_ = (int)wave_sum((float)mmg);
          const int s3_ = (int)wave_sum((float)mm3); if (lane == 0) atomicAdd((unsigned*)(ws + WS_CTL) + 67, (unsigned)s3_);
          if (lane == 0) { atomicAdd((unsigned*)(ws + WS_CTL) + 64, (unsigned)s1_); atomicAdd((unsigned*)(ws + WS_CTL) + 65, (unsigned)s2_); atomicAdd((unsigned*)(ws + WS_CTL) + 66, (unsigned)sg_); } }
#endif
#if defined(PEER_SLOW_GATHER)
        _Pragma("unroll 1") for (int tl = 0; tl < 4; ++tl) {
            const int t = t0 + tl; float xs[32], os[32]; int lq = lane; asm volatile("" : "+v"(lq));
            _Pragma("unroll") for (int j = 0; j < 32; ++j) { xs[j] = bf1(X2[(size_t)t * DM + lq + 64 * j]); os[j] = 0.f; }
            _Pragma("unroll 1") for (int hk = 0; hk < 128; ++hk) {
                const int e = idxs[tl * 128 + hk]; const float gt = gts[tl * 128 + hk];
                int lp = lane; asm volatile("" : "+v"(lp)); const float* ur = a.in[16] + (size_t)e * DM + lp; const float* vr = a.in[17] + (size_t)e * DM + lp;
                float hv = 0.f;
                _Pragma("unroll") for (int j = 0; j < 32; ++j) hv += ur[64 * j] * xs[j];
                hv = wave_sum(hv);
                const float av = gt * 0.5f * hv * (1.f + erff(hv * 0.7071067811865476f));
                _Pragma("unroll") for (int j = 0; j < 32; ++j) os[j] += av * vr[64 * j];
            }
            float sm = 0.f;
            _Pragma("unroll") for (int j = 0; j < 32; ++j) { os[j] += ALPHA * xs[j]; sm += os[j]; }
            const float mean = wave_sum(sm) * (1.f / DM); float s2 = 0.f;
            _Pragma("unroll") for (int j = 0; j < 32; ++j) { os[j] -= mean; s2 += os[j] * os[j]; }
            const float rstd = 1.f / sqrtf(wave_sum(s2) * (1.f / DM) + LN_EPS); int lr = lane; asm volatile("" : "+v"(lr));
            _Pragma("unroll") for (int j = 0; j < 32; ++j) a.out[(size_t)t * DM + lr + 64 * j] = os[j] * rstd * a.in[18][lr + 64 * j] + a.in[19][lr + 64 * j];
        }
        if (false)
#endif
        if (PEER_PARTS & 4) {
            const int lane = fresh_lane();
            struct RowB { u32x4 q; unsigned short sc; };
            RowB w0, w1, w2, w3, w4, w5, w6, w7, w8, w9, w10, w11, w12, w13, w14, w15;
            f32x2 o2[4][4], x2[4][4];
            int lane_g = lane; asm volatile("" : "+v"(lane_g));
            const unsigned lq16 = (unsigned)lane_g * 16u, lq2 = (unsigned)lane_g * 2u;
            LAS float* hpl = tops;
            LAS float* akl = (LAS float*)(lds + wave * PEER_WLDS + 8192);
#define PEER_LOADW(W, tab, e) do { const unsigned char* r0_ = (tab) + (unsigned)__builtin_amdgcn_readfirstlane(e) * (unsigned)EROW;        \
                W.q = *(const u32x4*)(r0_ + lq16); W.sc = *(const unsigned short*)(r0_ + 1024 + lq2); } while (0)
#define PEER_DEC8(w_) const f32x2 e0 = __builtin_amdgcn_cvt_scalef32_pk_f32_fp4(w_, 1.0f, 0), e1 = __builtin_amdgcn_cvt_scalef32_pk_f32_fp4(w_, 1.0f, 1), \
                                 e2 = __builtin_amdgcn_cvt_scalef32_pk_f32_fp4(w_, 1.0f, 2), e3 = __builtin_amdgcn_cvt_scalef32_pk_f32_fp4(w_, 1.0f, 3)
#define PEER_DOTU(W, k) do { f32x2 s0 = {0.f, 0.f}, s1 = {0.f, 0.f}; \
                _Pragma("unroll") for (int d_ = 0; d_ < 4; ++d_) { PEER_DEC8(W.q[d_]); \
                    s0 += e0 * x2[d_][0]; s1 += e1 * x2[d_][1]; s0 += e2 * x2[d_][2]; s1 += e3 * x2[d_][3]; } \
                s0 += s1; hpl[(k) * 64 + lane_g] = bitsf((unsigned)W.sc << 16) * (s0.x + s0.y); } while (0)
#define PEER_FMAV(W, k) do { const float av_ = bitsf((unsigned)__builtin_amdgcn_readlane((int)fbits(avv), 4 * (k))) * bitsf((unsigned)W.sc << 16); const f32x2 av = {av_, av_}; \
                _Pragma("unroll") for (int d_ = 0; d_ < 4; ++d_) { PEER_DEC8(W.q[d_]); \
                    o2[d_][0] += av * e0; o2[d_][1] += av * e1; o2[d_][2] += av * e2; o2[d_][3] += av * e3; } } while (0)
#define SB0() __builtin_amdgcn_sched_barrier(0)
            PEER_LOADW(w0, UT, idxs[0]); PEER_LOADW(w1, UT, idxs[1]); PEER_LOADW(w2, UT, idxs[2]); PEER_LOADW(w3, UT, idxs[3]);
            PEER_LOADW(w4, UT, idxs[4]); PEER_LOADW(w5, UT, idxs[5]); PEER_LOADW(w6, UT, idxs[6]); PEER_LOADW(w7, UT, idxs[7]);
            PEER_LOADW(w8, UT, idxs[8]); PEER_LOADW(w9, UT, idxs[9]); PEER_LOADW(w10, UT, idxs[10]); PEER_LOADW(w11, UT, idxs[11]);
            PEER_LOADW(w12, UT, idxs[12]); PEER_LOADW(w13, UT, idxs[13]); PEER_LOADW(w14, UT, idxs[14]);
            int iv_cur = idxs[lane_g & 15]; float avv = 0.f;
#pragma unroll 1
            for (int g = 0; g < 32; ++g) {
                const int tl = g >> 3, h = g & 7, t = t0 + tl;
                const LAS int* ipn = idxs + (g < 31 ? g + 1 : g) * 16;
                const int iv_nxt = ipn[lane_g & 15];
                if (h == 0) {
                    int lo_ = lane; asm volatile("" : "+v"(lo_));
                    const u32x2* xr = (const u32x2*)(X2 + (size_t)t * DM) + lo_;
#pragma unroll
                    for (int c = 0; c < 4; ++c) { const u32x2 p = xr[64 * (2 * c)], q = xr[64 * (2 * c + 1)];
                        x2[c][0] = (f32x2){bflo(p.x), bflo(q.x)}; x2[c][1] = (f32x2){bfhi(p.x), bfhi(q.x)}; x2[c][2] = (f32x2){bflo(p.y), bflo(q.y)}; x2[c][3] = (f32x2){bfhi(p.y), bfhi(q.y)}; }
                    { const f32x2 mr_ = ((const f32x2*)(ws + WS_MR))[t]; const float mean_ = mr_.x, rstd_ = mr_.y;
                      const LAS f32x4* gp_ = gb + lo_; const LAS f32x4* bp_ = gb + 512 + lo_;
                      _Pragma("unroll") for (int c = 0; c < 4; ++c) { const f32x4 g0 = gp_[128 * c], g1 = gp_[128 * c + 64], b0 = bp_[128 * c], b1 = bp_[128 * c + 64];
                          x2[c][0] = (f32x2){(x2[c][0].x - mean_) * rstd_ * g0.x + b0.x, (x2[c][0].y - mean_) * rstd_ * g1.x + b1.x};
                          x2[c][1] = (f32x2){(x2[c][1].x - mean_) * rstd_ * g0.y + b0.y, (x2[c][1].y - mean_) * rstd_ * g1.y + b1.y};
                          x2[c][2] = (f32x2){(x2[c][2].x - mean_) * rstd_ * g0.z + b0.z, (x2[c][2].y - mean_) * rstd_ * g1.z + b1.z};
                          x2[c][3] = (f32x2){(x2[c][3].x - mean_) * rstd_ * g0.w + b0.w, (x2[c][3].y - mean_) * rstd_ * g1.w + b1.w}; } }
#pragma unroll
                    for (int c = 0; c < 4; ++c)
#pragma unroll
                        for (int j = 0; j < 4; ++j) o2[c][j] = (f32x2){0.f, 0.f};
                }
#define PEER_PF(W, pr) do { const int pr_ = (pr); const unsigned char* tb_ = (pr_ & 16) ? VT : UT; PEER_LOADW(W, tb_, __builtin_amdgcn_readlane(pr_ >= 32 ? iv_nxt : iv_cur, pr_ & 15)); } while (0)
                {
                    PEER_PF(w15, 15); PEER_DOTU(w0, 0); SB0();
                    PEER_PF(w0, 16); PEER_DOTU(w1, 1); SB0();
                    PEER_PF(w1, 17); PEER_DOTU(w2, 2); SB0();
                    PEER_PF(w2, 18); PEER_DOTU(w3, 3); SB0();
                    PEER_PF(w3, 19); PEER_DOTU(w4, 4); SB0();
                    PEER_PF(w4, 20); PEER_DOTU(w5, 5); SB0();
                    PEER_PF(w5, 21); PEER_DOTU(w6, 6); SB0();
                    PEER_PF(w6, 22); PEER_DOTU(w7, 7); SB0();
                    PEER_PF(w7, 23); PEER_DOTU(w8, 8); SB0();
                    PEER_PF(w8, 24); PEER_DOTU(w9, 9); SB0();
                    PEER_PF(w9, 25); PEER_DOTU(w10, 10); SB0();
                    PEER_PF(w10, 26); PEER_DOTU(w11, 11); SB0();
                    PEER_PF(w11, 27); PEER_DOTU(w12, 12); SB0();
                    PEER_PF(w12, 28); PEER_DOTU(w13, 13); SB0();
                    PEER_PF(w13, 29); PEER_DOTU(w14, 14); SB0();
                    PEER_PF(w14, 30); PEER_DOTU(w15, 15); SB0();
                }
                {
                    LDS_WAIT();
                    const LAS f32x4* hp4 = (const LAS f32x4*)(hpl + (lane >> 2) * 64 + (lane & 3) * 16);
                    const f32x4 p0 = hp4[0], p1 = hp4[1], p2 = hp4[2], p3 = hp4[3];
                    float hv = ((p0.x + p0.y) + (p0.z + p0.w)) + ((p1.x + p1.y) + (p1.z + p1.w)) + ((p2.x + p2.y) + (p2.z + p2.w)) + ((p3.x + p3.y) + (p3.z + p3.w));
                    hv += dpp_xor1(hv); hv += dpp_xor2(hv);
                    avv = gts[g * 16 + (lane >> 2)] * 0.5f * hv * (1.f + erf_f32(hv * 0.7071067811865476f));
                    SB0();
                }
                {
                    PEER_PF(w15, 31); PEER_FMAV(w0, 0); SB0();
                    PEER_PF(w0, 32); PEER_FMAV(w1, 1); SB0();
                    PEER_PF(w1, 33); PEER_FMAV(w2, 2); SB0();
                    PEER_PF(w2, 34); PEER_FMAV(w3, 3); SB0();
                    PEER_PF(w3, 35); PEER_FMAV(w4, 4); SB0();
                    PEER_PF(w4, 36); PEER_FMAV(w5, 5); SB0();
                    PEER_PF(w5, 37); PEER_FMAV(w6, 6); SB0();
                    PEER_PF(w6, 38); PEER_FMAV(w7, 7); SB0();
                    PEER_PF(w7, 39); PEER_FMAV(w8, 8); SB0();
                    PEER_PF(w8, 40); PEER_FMAV(w9, 9); SB0();
                    PEER_PF(w9, 41); PEER_FMAV(w10, 10); SB0();
                    PEER_PF(w10, 42); PEER_FMAV(w11, 11); SB0();
                    PEER_PF(w11, 43); PEER_FMAV(w12, 12); SB0();
                    PEER_PF(w12, 44); PEER_FMAV(w13, 13); SB0();
                    PEER_PF(w13, 45); PEER_FMAV(w14, 14); SB0();
                    PEER_PF(w14, 46); PEER_FMAV(w15, 15); SB0();
                }
                if (h == 7) {
                    f32x2 s = {0.f, 0.f};
#pragma unroll
                    for (int c = 0; c < 4; ++c) {
#pragma unroll
                        for (int j = 0; j < 4; ++j) { o2[c][j] += ALPHA * x2[c][j]; s += o2[c][j]; } }
                    const float mean = wave_sum(s.x + s.y) * (1.f / DM); f32x2 s2 = {0.f, 0.f};
#pragma unroll
                    for (int c = 0; c < 4; ++c)
#pragma unroll
                        for (int j = 0; j < 4; ++j) { o2[c][j] -= mean; s2 += o2[c][j] * o2[c][j]; }
                    const float rstd = 1.f / sqrtf(wave_sum(s2.x + s2.y) * (1.f / DM) + LN_EPS);
                    int lo_ = lane; asm volatile("" : "+v"(lo_));
                    f32x4* orow = (f32x4*)(a.out + (size_t)t * DM) + lo_;
                    const LAS f32x4* g4 = gb + 1024 + lo_; const LAS f32x4* b4p = gb + 1536 + lo_;
#pragma unroll
                    for (int c = 0; c < 4; ++c) {
                        { const int m = 2 * c; const f32x4 gg = g4[64 * m], bb = b4p[64 * m];
                          orow[64 * m] = (f32x4){o2[c][0].x * rstd * gg.x + bb.x, o2[c][1].x * rstd * gg.y + bb.y, o2[c][2].x * rstd * gg.z + bb.z, o2[c][3].x * rstd * gg.w + bb.w}; SB0(); }
                        { const int m = 2 * c + 1; const f32x4 gg = g4[64 * m], bb = b4p[64 * m];
                          orow[64 * m] = (f32x4){o2[c][0].y * rstd * gg.x + bb.x, o2[c][1].y * rstd * gg.y + bb.y, o2[c][2].y * rstd * gg.z + bb.z, o2[c][3].y * rstd * gg.w + bb.w}; SB0(); }
                    }
                }
                iv_cur = iv_nxt;
            }
#undef PEER_LOADW
#undef PEER_PF
#undef PEER_DEC8
#undef PEER_DOTU
#undef PEER_FMAV
#undef SB0
        }
        LDS_WAIT();
    }
}


#define XB_TMO      128
#define XB_XCNT(j)  (256  + 64 * (j))
#define XB_XSUB(j)  (1280 + 64 * (j))
#define XB_XGEN(j)  (2304 + 64 * (j))
#define XB_TOP      3328
#define XB_TOPGEN   3392
#define XB_SPIN_CAP (1u << 22)
constexpr int CW_BAR = 4096;
__device__ __forceinline__ unsigned xb_ld(unsigned* p)              { return __hip_atomic_load(p, __ATOMIC_RELAXED, __HIP_MEMORY_SCOPE_AGENT); }
__device__ __forceinline__ unsigned xb_add(unsigned* p, unsigned v) { return __hip_atomic_fetch_add(p, v, __ATOMIC_RELAXED, __HIP_MEMORY_SCOPE_AGENT); }
__device__ __forceinline__ unsigned xb_xcc_id() { return (unsigned)__builtin_amdgcn_s_getreg((3 << 11) | 20) & 0xFu; }
#define XB_SPIN(cond, bar) do { unsigned _sp = 0; while (cond) { __builtin_amdgcn_s_sleep(1); \
    if ((++_sp & 255u) == 0u) { if (xb_ld(&(bar)[XB_TMO])) break; if (_sp > XB_SPIN_CAP) { atomicAdd(&(bar)[XB_TMO], 1u); break; } } } } while (0)
struct XcdBarrier { unsigned* bar; unsigned x; volatile LAS unsigned* st; };
__device__ __forceinline__ XcdBarrier xcd_barrier_post(unsigned* bar, volatile LAS unsigned* st, bool leader) {
    XcdBarrier b; b.bar = bar; b.x = xb_xcc_id(); b.st = st;
    if (leader) (void)xb_add(&bar[XB_XCNT(b.x)], 1u);
    return b;
}
__device__ __forceinline__ void xcd_barrier_complete(unsigned* bar, unsigned x, unsigned& nloc, unsigned& nx, unsigned G) {
    unsigned sum, cnt, mine, sp = 0u;
    for (;;) {
        sum = 0u; cnt = 0u; mine = 0u;
#pragma unroll
        for (unsigned j = 0; j < 16; ++j) { const unsigned c = xb_ld(&bar[XB_XCNT(j)]); sum += c; cnt += (c > 0u) ? 1u : 0u; mine = (j == x) ? c : mine; }
        if (sum == G) break;
        __builtin_amdgcn_s_sleep(1);
        if ((++sp & 255u) == 0u) { if (xb_ld(&bar[XB_TMO])) break; if (sp > XB_SPIN_CAP) { atomicAdd(&bar[XB_TMO], 1u); break; } }
    }
    nloc = mine > 0u ? mine : 1u; nx = cnt > 0u ? cnt : 1u;
}
__device__ __forceinline__ void xcd_barrier(const XcdBarrier& b, bool leader, unsigned G) {
    asm volatile("s_waitcnt vmcnt(0)" ::: "memory");
    __syncthreads();
    if (leader) {
        unsigned* bar = b.bar;
        __builtin_amdgcn_s_waitcnt(0);
        unsigned nloc = b.st[0], nx = b.st[1];
        if (nloc == 0u) { xcd_barrier_complete(bar, b.x, nloc, nx, G); b.st[0] = nloc; b.st[1] = nx; }
        const unsigned old = xb_add(&bar[XB_XSUB(b.x)], 1u);
        const unsigned gen = old / nloc;
        if (old + 1u == (gen + 1u) * nloc) {
            __builtin_amdgcn_fence(__ATOMIC_RELEASE, "agent");
            asm volatile("s_waitcnt vmcnt(0)" ::: "memory");
            const unsigned og = xb_add(&bar[XB_TOP], 1u);
            const unsigned tg = og / nx;
            if (og + 1u == (tg + 1u) * nx) xb_add(&bar[XB_TOPGEN], 1u);
            else XB_SPIN(xb_ld(&bar[XB_TOPGEN]) == tg, bar);
            __builtin_amdgcn_fence(__ATOMIC_ACQUIRE, "agent");
            xb_add(&bar[XB_XGEN(b.x)], 1u);
            asm volatile("s_waitcnt vmcnt(0)" ::: "memory");
        } else {
            XB_SPIN(xb_ld(&bar[XB_XGEN(b.x)]) == gen, bar);
            __builtin_amdgcn_fence(__ATOMIC_ACQUIRE, "agent");
            asm volatile("s_waitcnt vmcnt(0)" ::: "memory");
        }
    }
    __syncthreads();
}
__global__ void __launch_bounds__(NTHREADS, 2) fwd_kernel(Args a) {
    extern __shared__ __attribute__((aligned(16))) unsigned char lds_raw[];
    LAS unsigned char* lds = (LAS unsigned char*)lds_raw;
    const int tid = threadIdx.x, lane = tid & 63, wave = __builtin_amdgcn_readfirstlane(tid >> 6);
    const int G = gridDim.x, blk = blockIdx.x;
    const int gw = blk * NWAVES + wave, NGW = G * NWAVES;
    unsigned char* ws = a.ws;
#ifndef PH_MASK
#define PH_MASK 0xFFFF
#endif
#ifndef REPEAT_PH
#define REPEAT_PH -1
#endif
#define IN(k) (((PH_MASK >> (k)) & 1) && a.ph_lo <= (k) && (k) < a.ph_hi)
#define REP(k) for (int rep_ = 0; rep_ < ((k) == REPEAT_PH ? 2 : 1); ++rep_)
#if N_LAUNCH_MODE == 1
    cg::grid_group grid = cg::this_grid();
    volatile LAS unsigned* bst = (volatile LAS unsigned*)(lds + LDS_BYTES - 64);
    if (tid < 2) bst[tid] = 0u;
    __syncthreads();
    const XcdBarrier xbar = xcd_barrier_post((unsigned*)(ws + WS_CTL) + CW_BAR, bst, tid == 0);
#define SEAM(k) do { if (IN(k) && IN((k) + 1)) { if ((k) == 0 && a.ph_hi > 64) grid.sync(); else xcd_barrier(xbar, tid == 0, (unsigned)G); } } while (0)
#else
#define SEAM(k) do { } while (0)
#endif
    if (IN(0)) REP(0) { p0_prologue(a, lds, gw, NGW, wave, lane); }
    SEAM(0);
    if (IN(1)) REP(1) {
        pg8::Gemm g{DM, DM, DM};
        SchedP1 S{(const char*)(ws + WS_XB), (const char*)(ws + WS_WIN), (const char*)(ws + WS_MEMB), (const char*)(ws + WS_WMKV), G, blk, 0, 768};
        EpiP1 E{(bf16_t*)(ws + WS_PROJ), (bf16_t*)(ws + WS_KM), (bf16_t*)(ws + WS_VMT), (const f32x2*)(ws + WS_ROPE)};
        pg8::gemm_phase(lds, g, S, E);
    }
    SEAM(1);
#if ATTN_FAST && N_LAUNCH_MODE == 1
    if (IN(2)) REP(2) { attn_fast_phase(a, lds, (bf16_t*)(ws + WS_MIX), blk, G); p0_late(a, lds, gw, NGW, wave, lane); }
#elif ATTN_FAST
#else
    if (IN(2)) REP(2) { attn_naive_phase(a, lds, gw, NGW, wave, lane); }
#endif
    SEAM(2);
    if (IN(3)) REP(3) {
        pg8::Gemm g{DM, DM, DM};
        SchedSimple S{(const char*)(ws + WS_MIX), (const char*)(ws + WS_WO), 32, 8, G, blk, (size_t)256 * DM * 2, (size_t)256 * DM * 2};
        EpiRes<true> E{(const void*)(ws + WS_XB), (bf16_t*)(ws + WS_Y)};
        pg8::gemm_phase(lds, g, S, E);
    }
    SEAM(3);
    if (IN(4)) REP(4) {
        if (blk < 64) {
            pg8::Gemm g{512, DM, DM};
            SchedMKV S{(const char*)(ws + WS_MEMB), (const char*)(ws + WS_WMKV), blk};
            EpiMKV E{(float*)(ws + WS_PART)};
            pg8::gemm_phase(lds, g, S, E);
        } else { ln_phase((const bf16_t*)(ws + WS_Y), (bf16_t*)(ws + WS_X1), a.in[7], a.in[8], gw - 64 * NWAVES, NGW - 64 * NWAVES, lane);
            LAS float* scr = (LAS float*)(lds + wave * 16384);
            for (int item = gw - 64 * NWAVES; item < 32 * (DM / 32); item += NGW - 64 * NWAVES) pq_transpose_item(a.in[14], a.in[12], a.in[13], (bf16_t*)(ws + WS_WPQ), (float*)(ws + WS_P1), (float*)(ws + WS_P2), scr, item, lane);
            for (int r = 2 * NEXP - NE_P4 + gw - 64 * NWAVES; r < 2 * NEXP; r += NGW - 64 * NWAVES) cvt_expert_idx(a, r, lane); }
    }
    SEAM(4);
    if (IN(5)) REP(5) { mkv_reduce((const float*)(ws + WS_PART), (bf16_t*)(ws + WS_KM), (bf16_t*)(ws + WS_VMT), blk * NTHREADS + tid, G * NTHREADS);
        { const int n = blk * NTHREADS + tid; if (n < DM) { const float* P1 = (const float*)(ws + WS_P1); const float* P2 = (const float*)(ws + WS_P2); float c1 = 0.f, c2 = 0.f;
            for (int kb = 0; kb < 32; ++kb) { c1 += P1[(size_t)kb * DM + n]; c2 += P2[(size_t)kb * DM + n]; }
            ((f32x2*)(ws + WS_C12))[n] = (f32x2){c1, c2}; } } }
    SEAM(5);
    if (IN(6)) REP(6) {
        if (blk < 32) {
            pg8::Gemm g{512, DM, DM};
            SchedMT S{(const char*)(ws + WS_KM), (const char*)(ws + WS_WMQ), blk};
            EpiBf16 E{(bf16_t*)(ws + WS_MT), DM, C_XA};
            pg8::gemm_phase(lds, g, S, E);
        } else if (blk < 64) {
            pg8::Gemm g{512, DM, DM};
            SchedVW S{(const char*)(ws + WS_WMO), (const char*)(ws + WS_VMT), blk - 32};
            EpiBf16 E{(bf16_t*)(ws + WS_VWT), 1024, 1.f};
            pg8::gemm_phase(lds, g, S, E);
        } else {
            for (int r = NE_P0 + gw - 64 * NWAVES; r < NE_P0 + NE_T6; r += NGW - 64 * NWAVES) cvt_expert_idx(a, r, lane);
        }
    }
    SEAM(6);
    if (IN(6) && IN(7)) {
        pg8::Gemm g{DM, DM, DM};
        SchedSimple S{(const char*)(ws + WS_X1), (const char*)(ws + WS_MT), 32, 4, G, blk, (size_t)256 * DM * 2, (size_t)256 * DM * 2};
        EpiSoftmaxP E{(bf16_t*)(ws + WS_OM), lds};
        pg8::gemm_phase(lds, g, S, E);
        if (blk >= 128) { for (int r = NE_P0 + NE_T6 + gw - 128 * NWAVES; r < 2 * NEXP - NE_P4; r += NGW - 128 * NWAVES) cvt_expert_idx(a, r, lane); }
        xcd_barrier(xbar, tid == 0, (unsigned)G);
    }
    if (IN(7)) REP(7) {
        pg8::Gemm g{1024, 1024, 1024};
        SchedSimple S{(const char*)(ws + WS_OM), (const char*)(ws + WS_VWT), 32, 8, G, blk, (size_t)256 * 1024 * 2, (size_t)256 * 1024 * 2};
        EpiResStats E{(const bf16_t*)(ws + WS_X1), (bf16_t*)(ws + WS_Y), (f32x2*)(ws + WS_PS)};
        pg8::gemm_phase(lds, g, S, E);
    }
    SEAM(7);
    if (IN(9)) REP(9) {
        pg8::Gemm g{DM, DM, DM};
        SchedSimple S{(const char*)(ws + WS_Y), (const char*)(ws + WS_WPQ), 32, 8, G, blk, (size_t)256 * DM * 2, (size_t)256 * DM * 2};
        EpiPQ E{(bf16_t*)(ws + WS_QP), (const f32x2*)(ws + WS_PS), (const f32x2*)(ws + WS_C12), (f32x2*)(ws + WS_MR)};
        pg8::gemm_phase(lds, g, S, E);
    }
    SEAM(9);
    if (IN(10)) REP(10) { peer_phase(a, lds, blk, G, wave, lane); }
#if defined(PEER_DBG_CMP)
    if (a.ph_lo == 11) { const unsigned cnt = ((const unsigned*)(ws + WS_CTL))[64 + PEER_DBG_CMP - 1]; const float frac = (float)cnt / (PEER_DBG_CMP == 1 ? 8192.f * 8 * 32 : (PEER_DBG_CMP == 4 ? 8192.f * 8 * 256 : 8192.f * 128));
        const float cval = 10.f * frac; for (size_t i = (size_t)blk * NTHREADS + tid; i < (size_t)SEQ * DM; i += (size_t)G * NTHREADS) a.out[i] = cval; }
#endif
#undef IN
#undef SEAM
}

#if ATTN_FAST && N_LAUNCH_MODE == 0
__global__ void __launch_bounds__(NTHREADS, 2) attn_kernel(Args a) {
    extern __shared__ __attribute__((aligned(16))) unsigned char lds_raw[];
    attn_fast_phase(a, (LAS unsigned char*)lds_raw, (bf16_t*)(a.ws + WS_MIX), blockIdx.x, gridDim.x);
}
#endif
#if defined(PEER_DBG_CMP)
constexpr int N_PHASES = 12;
#else
constexpr int N_PHASES = 11;
#endif
extern "C" void kernel_launch(void* const* d_in, const int* in_sizes, int n_in, void* d_out, int out_size, void* d_ws, size_t ws_size, hipStream_t stream) {
    static int grid = 0;
    if (grid == 0) {
        if (n_in != 20 || in_sizes[0] != SEQ * DM || out_size != SEQ * DM || ws_size < WS_END) {
            fprintf(stderr, "kernel_launch: unexpected shapes: n_in %d in0 %d out %d ws %zu (need %zu)\n", n_in, n_in > 0 ? in_sizes[0] : -1, out_size, ws_size, (size_t)WS_END);
            grid = -1; return; }
        int dev = 0, cus = 0, per_cu = 0;
        (void)hipGetDevice(&dev); (void)hipDeviceGetAttribute(&cus, hipDeviceAttributeMultiprocessorCount, dev);
#if ATTN_FAST && N_LAUNCH_MODE == 0
        (void)hipFuncSetAttribute((const void*)attn_kernel, hipFuncAttributeMaxDynamicSharedMemorySize, LDS_BYTES);
#endif
        if (hipFuncSetAttribute((const void*)fwd_kernel, hipFuncAttributeMaxDynamicSharedMemorySize, LDS_BYTES) != hipSuccess) { fprintf(stderr, "kernel_launch: hipFuncSetAttribute failed\n"); grid = -1; return; }
        if (hipOccupancyMaxActiveBlocksPerMultiprocessor(&per_cu, (const void*)fwd_kernel, NTHREADS, LDS_BYTES) != hipSuccess || per_cu < 1) { fprintf(stderr, "kernel_launch: occupancy query says %d\n", per_cu); per_cu = 1; }
        (void)hipGetLastError();
        if (cus <= 0) cus = 256;
        grid = cus;
    }
    if (grid < 0) return;
    (void)hipMemsetAsync((char*)d_ws + WS_CTL, 0, 64 * 1024, stream);
    Args a{};
    for (int i = 0; i < 20; ++i) a.in[i] = (const float*)d_in[i];
    a.out = (float*)d_out; a.ws = (unsigned char*)d_ws;
#if N_LAUNCH_MODE == 1
    a.ph_lo = 0; a.ph_hi = N_PHASES;
    void* args[] = {&a};
    hipError_t e = hipLaunchCooperativeKernel((const void*)fwd_kernel, dim3(grid), dim3(NTHREADS), args, LDS_BYTES, stream);
    if (e != hipSuccess) fprintf(stderr, "kernel_launch: cooperative launch failed: %s\n", hipGetErrorString(e));
#else
    for (int p = 0; p < N_PHASES; ++p) {
        a.ph_lo = p; a.ph_hi = p + 1;
#if ATTN_FAST
        if (p == 2) { hipLaunchKernelGGL(attn_kernel, dim3(grid), dim3(NTHREADS), LDS_BYTES, stream, a); continue; }
#endif
        hipLaunchKernelGGL(fwd_kernel, dim3(grid), dim3(NTHREADS), LDS_BYTES, stream, a);
    }
    const hipError_t le = hipPeekAtLastError();
    if (le != hipSuccess) fprintf(stderr, "kernel_launch: launch failed: %s\n", hipGetErrorName(le));
#endif
}
```

```cpp
#include <hip/hip_runtime.h>
#include <hip/hip_cooperative_groups.h>
#include <cstdio>
#include <cstdint>
namespace cg = cooperative_groups;

#ifndef N_LAUNCH_MODE
#define N_LAUNCH_MODE 1
#endif
#ifndef ATTN_FAST
#define ATTN_FAST 1
#endif
#ifndef XATTN_FAST
#define XATTN_FAST 1
#endif

#define LAS __attribute__((address_space(3)))
#define GAS __attribute__((address_space(1)))
typedef unsigned short bf16_t;
typedef short bf16x8 __attribute__((ext_vector_type(8)));
typedef short s16x4 __attribute__((ext_vector_type(4)));
typedef float f32x2 __attribute__((ext_vector_type(2)));
typedef float f32x4 __attribute__((ext_vector_type(4)));
typedef float f32x16 __attribute__((ext_vector_type(16)));
typedef unsigned u32x2 __attribute__((ext_vector_type(2)));
typedef unsigned u32x4 __attribute__((ext_vector_type(4)));
typedef __bf16 bf16x2_t __attribute__((ext_vector_type(2)));

constexpr int SEQ = 8192, DM = 2048, MEM = 256, INW = 6144, NEXP = 16384;
constexpr float ALPHA = 1.189207115002721f;
constexpr float LOG2E = 1.4426950408889634f;
constexpr float C_SB = 0.12751743082459868f;
constexpr float C_DF = 0.18033688011112042f;
constexpr float C_XA = 0.06375871541229934f;
constexpr float LAMBDA_INIT = 0.2f;
constexpr float LN_EPS = 1e-5f, RMS_EPS = 1e-6f;
constexpr int NWAVES = 8, NTHREADS = 512;

constexpr size_t MiB = 1u << 20;
constexpr size_t WS_CTL = 0;
constexpr size_t WS_ROPE = 1 * MiB;
constexpr size_t WS_KEYS = 1 * MiB + 512 * 1024;
constexpr size_t WS_MEMB = 2 * MiB;
constexpr size_t WS_KM = 3 * MiB;
constexpr size_t WS_VMT = 4 * MiB;
constexpr size_t WS_WIN = 8 * MiB;
constexpr size_t WS_WO = 32 * MiB;
constexpr size_t WS_WMQ = 40 * MiB;
constexpr size_t WS_WMKV = 48 * MiB;
constexpr size_t WS_WMO = 64 * MiB;
constexpr size_t WS_WPQ = 72 * MiB;
constexpr size_t WS_XB = 80 * MiB;
constexpr size_t WS_QP = 80 * MiB;
constexpr size_t WS_PROJ = 112 * MiB;
constexpr size_t WS_QM = 112 * MiB, WS_OM = 144 * MiB, WS_X2 = 176 * MiB;
constexpr size_t WS_MT = 196 * MiB;
constexpr size_t WS_VWT = 192 * MiB;
constexpr size_t WS_PART = 176 * MiB;
constexpr size_t WS_P1 = 204 * MiB, WS_P2 = 204 * MiB + 256 * 1024, WS_C12 = 204 * MiB + 512 * 1024, WS_MR = 204 * MiB + 576 * 1024, WS_PS = 205 * MiB;
constexpr size_t WS_MIX = 208 * MiB;
constexpr size_t WS_Y = 240 * MiB;
constexpr size_t WS_X1 = 304 * MiB;
constexpr size_t WS_UT = 344 * MiB;
constexpr size_t WS_VT = 376 * MiB;
constexpr size_t WS_END = 409 * MiB;
constexpr size_t PROJ_SEC = (size_t)SEQ * 1024;
constexpr int CW_LAM = 16;

constexpr int LDS_BYTES = 147456;

__device__ __forceinline__ unsigned f2bf(float f) { unsigned u = __builtin_bit_cast(unsigned, f); return (u + 0x7fffu + ((u >> 16) & 1u)) >> 16; }
__device__ __forceinline__ unsigned pk2(float lo, float hi) { return f2bf(lo) | (f2bf(hi) << 16); }
__device__ __forceinline__ unsigned cvtpk(float lo, float hi) { unsigned r; asm volatile("v_cvt_pk_bf16_f32 %0, %1, %2" : "=v"(r) : "v"(lo), "v"(hi)); return r; }
__device__ __forceinline__ unsigned fbits(float f) { return __builtin_bit_cast(unsigned, f); }
__device__ __forceinline__ float bitsf(unsigned u) { return __builtin_bit_cast(float, u); }
__device__ __forceinline__ float bflo(unsigned w) { return __builtin_bit_cast(float, w << 16); }
__device__ __forceinline__ float bfhi(unsigned w) { return __builtin_bit_cast(float, w & 0xffff0000u); }
__device__ __forceinline__ float bf1(bf16_t h) { return __builtin_bit_cast(float, (unsigned)h << 16); }
__device__ __forceinline__ float dpp_xor1(float v) { return __builtin_bit_cast(float, __builtin_amdgcn_update_dpp(0, __builtin_bit_cast(int, v), 0xB1, 0xF, 0xF, true)); }
__device__ __forceinline__ float dpp_xor2(float v) { return __builtin_bit_cast(float, __builtin_amdgcn_update_dpp(0, __builtin_bit_cast(int, v), 0x4E, 0xF, 0xF, true)); }
__device__ __forceinline__ float wave_sum(float v) {
    v += dpp_xor1(v); v += dpp_xor2(v);
    v += __builtin_bit_cast(float, __builtin_amdgcn_update_dpp(0, __builtin_bit_cast(int, v), 0x141, 0xF, 0xF, true));
    v += __builtin_bit_cast(float, __builtin_amdgcn_update_dpp(0, __builtin_bit_cast(int, v), 0x140, 0xF, 0xF, true));
    const int b = __builtin_bit_cast(int, v);
    return (__builtin_bit_cast(float, __builtin_amdgcn_readlane(b, 0)) + __builtin_bit_cast(float, __builtin_amdgcn_readlane(b, 16)))
         + (__builtin_bit_cast(float, __builtin_amdgcn_readlane(b, 32)) + __builtin_bit_cast(float, __builtin_amdgcn_readlane(b, 48)));
}
__device__ __forceinline__ float lane_xor16(float v) { float v2 = v; asm volatile("" : "+v"(v2));
    auto rr = __builtin_amdgcn_permlane16_swap(__builtin_bit_cast(unsigned, v), __builtin_bit_cast(unsigned, v2), false, false);
    const unsigned a_ = rr[0], b_ = rr[1]; return __builtin_bit_cast(float, (threadIdx.x & 16) ? a_ : b_); }
__device__ __forceinline__ float lane_xor32(float v) { float v2 = v; asm volatile("" : "+v"(v2));
    auto rr = __builtin_amdgcn_permlane32_swap(__builtin_bit_cast(unsigned, v), __builtin_bit_cast(unsigned, v2), false, false);
    const unsigned a_ = rr[0], b_ = rr[1]; return __builtin_bit_cast(float, (threadIdx.x & 32) ? a_ : b_); }
__device__ __forceinline__ float half32_sum(float v) {
    v += dpp_xor1(v); v += dpp_xor2(v);
    v += __builtin_bit_cast(float, __builtin_amdgcn_update_dpp(0, __builtin_bit_cast(int, v), 0x141, 0xF, 0xF, true));
    v += __builtin_bit_cast(float, __builtin_amdgcn_update_dpp(0, __builtin_bit_cast(int, v), 0x140, 0xF, 0xF, true));
    return v + lane_xor16(v);
}
__device__ __forceinline__ float wave_max(float v) {
#pragma unroll
    for (int o = 1; o < 64; o <<= 1) v = fmaxf(v, __shfl_xor(v, o));
    return v;
}
__device__ __forceinline__ float dot2bf(unsigned w, unsigned x, float acc) {
    return __builtin_amdgcn_fdot2_f32_bf16(__builtin_bit_cast(bf16x2_t, w), __builtin_bit_cast(bf16x2_t, x), acc, false);
}
__device__ __forceinline__ int crow(int r, int hi) { return (r & 3) + 8 * (r >> 2) + 4 * hi; }
#define LDS_WAIT() asm volatile("s_waitcnt lgkmcnt(0)" ::: "memory")
#define VM_WAIT() asm volatile("s_waitcnt vmcnt(0)" ::: "memory")

namespace pg8 {
constexpr int BM = 256, BK = 64, HALF = 128, HTB = HALF * BK * 2, STAGE_BYTES = 8 * HTB, NXCD = 8, WGM = 8;
__host__ __device__ __forceinline__ int lds_byte(int r, int c) { const int st = (r >> 4) * 2 + (c >> 5), rr = r & 15, cc = c & 31, ob = rr * 64 + cc * 2; return st * 1024 + (ob ^ (((ob >> 9) & 1) << 5)); }
__host__ __device__ __forceinline__ void stage_rc(int b, int& R, int& C) { const int st = b / 1024, sb = b % 1024, swz = sb ^ (((sb >> 9) & 1) << 5); R = (st >> 1) * 16 + swz / 64; C = (st & 1) * 32 + (swz % 64) / 2; }
__host__ __device__ __forceinline__ int perm32(int rho) { const int n = rho >> 4, i = rho & 15; return 8 * (i >> 2) + 4 * n + (i & 3); }

struct Unit { int pm, pn, kind; const char* A; const char* B; };
struct Gemm { int K, lda, ldb; };

__device__ __forceinline__ bool tile_of(long L, int nM, int nN, int& pm, int& pn) {
    const int nwg = nM * nN; if (L >= nwg) return false;
    int wgid = (int)L; { const int q = nwg / NXCD, r = nwg % NXCD, xcd = wgid % NXCD, off = wgid / NXCD; wgid = (xcd < r ? xcd * (q + 1) : r * (q + 1) + (xcd - r) * q) + off; }
    const int nig = WGM * nN, gid = wgid / nig, fm = gid * WGM, gsz = (nM - fm) < WGM ? (nM - fm) : WGM;
    pm = fm + ((wgid % nig) % gsz); pn = (wgid % nig) / gsz; return true;
}

template <class Epi, class Sched>
__device__ __forceinline__ void gemm_phase(LAS unsigned char* lds, const Gemm g, const Sched& S, const Epi& E) {
    const int tid = threadIdx.x, wid = __builtin_amdgcn_readfirstlane(tid >> 6), lane = tid & 63, wr = wid >> 2, wc = wid & 3, fr = lane & 15, fq = lane >> 4;
    const int K = g.K, nt = K / BK;
    unsigned voffA[2], voffB[2];
#pragma unroll
    for (int i = 0; i < 2; ++i) { int R, C; stage_rc(tid * 16 + i * 8192, R, C); const int Rb = (R & ~31) + perm32(R & 31);
        voffA[i] = (unsigned)(R * g.lda + C) * 2u; voffB[i] = (unsigned)(Rb * g.ldb + C) * 2u; }
    const size_t kstep = (size_t)(BK * 2);
    const size_t hstepA = (size_t)HALF * g.lda * 2, hstepB = (size_t)HALF * g.ldb * 2;
    const unsigned ldsw = (unsigned)wid * 1024u;
    const int aoff = lds_byte(wr * 64 + fr, fq * 8), boff = lds_byte(wc * 32 + fr, fq * 8);
#define PG8_SA(b, h) (((b) * 2 + (h)) * HTB)
#define PG8_SB(b, h) ((4 + (b) * 2 + (h)) * HTB)
#define PG8_STAGE(bufoff, gbase, voff) do { _Pragma("unroll") for (int _i = 0; _i < 2; ++_i) \
        __builtin_amdgcn_global_load_lds((const unsigned*)((const char*)(gbase) + (voff)[_i]), (LAS unsigned*)(lds + (bufoff) + ldsw + _i * 8192), 16, 0, 0); } while (0)
#define PG8_LDA(dst, b, h) do { _Pragma("unroll") for (int m = 0; m < 4; ++m) _Pragma("unroll") for (int k = 0; k < 2; ++k) dst[m][k] = *(const LAS bf16x8*)(lds + PG8_SA(b, h) + aoff + m * 2048 + k * 1024); } while (0)
#define PG8_LDB(dst, b, h) do { _Pragma("unroll") for (int n = 0; n < 2; ++n) _Pragma("unroll") for (int k = 0; k < 2; ++k) dst[n][k] = *(const LAS bf16x8*)(lds + PG8_SB(b, h) + boff + n * 2048 + k * 1024); } while (0)
#define PG8_MMA(ai, bj, At, Bt) do { __builtin_amdgcn_s_setprio(1); _Pragma("unroll") for (int m = 0; m < 4; ++m) _Pragma("unroll") for (int n = 0; n < 2; ++n) _Pragma("unroll") for (int k = 0; k < 2; ++k) \
        acc[ai][bj][m][n] = __builtin_amdgcn_mfma_f32_16x16x32_bf16(Bt[n][k], At[m][k], acc[ai][bj][m][n], 0, 0, 0); __builtin_amdgcn_s_setprio(0); } while (0)
#define PG8_WAIT_V(n) asm volatile("s_waitcnt vmcnt(" #n ")" ::: "memory")
#define PG8_WAIT_L(n) asm volatile("s_waitcnt lgkmcnt(" #n ")" ::: "memory")
#define PG8_BAR __builtin_amdgcn_s_barrier()
#define PG8_SCHED __builtin_amdgcn_sched_barrier(0)
    Unit cur, nxt; int ui = 0;
    if (!S.next(0, cur)) return;
    f32x4 acc[2][2][4][2];
#pragma unroll
    for (int a = 0; a < 2; ++a)
#pragma unroll
        for (int b = 0; b < 2; ++b)
#pragma unroll
            for (int m = 0; m < 4; ++m)
#pragma unroll
                for (int n = 0; n < 2; ++n) acc[a][b][m][n] = (f32x4){0.f, 0.f, 0.f, 0.f};
    bf16x8 At[4][2], B0[2][2], B1[2][2];
    const char* cA = cur.A; const char* cB = cur.B;
    PG8_STAGE(PG8_SB(0, 0), cB, voffB); PG8_STAGE(PG8_SB(0, 1), cB + hstepB, voffB); PG8_STAGE(PG8_SA(0, 0), cA, voffA); PG8_STAGE(PG8_SA(0, 1), cA + hstepA, voffA);
    if (wr == 1) PG8_BAR;
    PG8_WAIT_V(2); PG8_BAR;
    PG8_STAGE(PG8_SB(1, 0), cB + kstep, voffB); PG8_STAGE(PG8_SA(1, 0), cA + kstep, voffA); PG8_STAGE(PG8_SB(1, 1), cB + hstepB + kstep, voffB);
    PG8_WAIT_V(6); PG8_BAR;
    for (;;) {
        const bool has_next = S.next(ui + 1, nxt);
        const char* nA = has_next ? nxt.A : cA; const char* nB = has_next ? nxt.B : cB;
        for (int t = 0; t < nt; t += 2) {
            const bool last = (t == nt - 2);
            const char* a1 = cA + (size_t)(t + 1) * kstep;
            const char* a2 = last ? nA : cA + (size_t)(t + 2) * kstep; const char* b2 = last ? nB : cB + (size_t)(t + 2) * kstep;
            const char* a3 = a2 + kstep; const char* b3 = b2 + kstep;
            PG8_LDB(B0, 0, 0); PG8_LDB(B1, 0, 1); PG8_SCHED; PG8_LDA(At, 0, 0); PG8_STAGE(PG8_SA(1, 1), a1 + hstepA, voffA);
            PG8_WAIT_V(8); PG8_WAIT_L(0); PG8_BAR; PG8_MMA(0, 0, At, B0); PG8_MMA(0, 1, At, B1); PG8_BAR; PG8_SCHED;
            PG8_LDA(At, 0, 1); PG8_STAGE(PG8_SB(0, 0), b2, voffB); PG8_STAGE(PG8_SB(0, 1), b2 + hstepB, voffB); PG8_STAGE(PG8_SA(0, 0), a2, voffA);
            PG8_WAIT_V(8); PG8_WAIT_L(0); PG8_BAR; PG8_MMA(1, 0, At, B0); PG8_MMA(1, 1, At, B1); PG8_BAR; PG8_SCHED;
            PG8_LDB(B0, 1, 0); PG8_LDB(B1, 1, 1); PG8_SCHED; PG8_LDA(At, 1, 0); PG8_STAGE(PG8_SA(0, 1), a2 + hstepA, voffA);
            PG8_WAIT_V(8); PG8_WAIT_L(0); PG8_BAR; PG8_MMA(0, 0, At, B0); PG8_MMA(0, 1, At, B1); PG8_BAR; PG8_SCHED;
            PG8_LDA(At, 1, 1); PG8_STAGE(PG8_SB(1, 0), b3, voffB); PG8_STAGE(PG8_SB(1, 1), b3 + hstepB, voffB); PG8_STAGE(PG8_SA(1, 0), a3, voffA);
            PG8_WAIT_V(8); PG8_WAIT_L(0); PG8_BAR; PG8_MMA(1, 0, At, B0); PG8_MMA(1, 1, At, B1); PG8_BAR; PG8_SCHED;
        }
        if (wr == 0) PG8_BAR;
        E(acc, cur, wr, wc, fr, fq);
        if (!has_next) break;
#pragma unroll
        for (int a = 0; a < 2; ++a)
#pragma unroll
            for (int b = 0; b < 2; ++b)
#pragma unroll
                for (int m = 0; m < 4; ++m)
#pragma unroll
                    for (int n = 0; n < 2; ++n) acc[a][b][m][n] = (f32x4){0.f, 0.f, 0.f, 0.f};
        cur = nxt; cA = nA; cB = nB; ++ui;
        if (wr == 1) PG8_BAR;
    }
    PG8_WAIT_V(0);
    PG8_BAR;
#undef PG8_SA
#undef PG8_SB
#undef PG8_STAGE
#undef PG8_LDA
#undef PG8_LDB
#undef PG8_MMA
#undef PG8_WAIT_V
#undef PG8_WAIT_L
#undef PG8_BAR
#undef PG8_SCHED
}
}

struct Args {
    const float* in[20];
    float* out;
    unsigned char* ws;
    int ph_lo, ph_hi;
};

struct SchedSimple {
    const char* A; const char* B; int nM, nN, G, c; size_t tA, tB;
    __device__ __forceinline__ bool next(int i, pg8::Unit& u) const {
        int pm, pn; if (!pg8::tile_of((long)i * G + c, nM, nN, pm, pn)) return false;
        u.pm = pm; u.pn = pn; u.kind = 0; u.A = A + (size_t)pm * tA; u.B = B + (size_t)pn * tB; return true;
    }
};
struct SchedP1 {
    const char* xb; const char* win; const char* memb; const char* wmkv; int G, c; int base, lim;
    __device__ __forceinline__ bool next(int i, pg8::Unit& u) const {
        const long L = (long)i * G + c + base; constexpr size_t T = (size_t)256 * DM * 2;
        if (L >= lim) return false;
        if (L < 768) { int pm, pn; pg8::tile_of(L, 32, 24, pm, pn); u.pm = pm; u.pn = pn; u.kind = 0; u.A = xb + (size_t)pm * T; u.B = win + (size_t)pn * T; return true; }
        const int e = (int)(L - 768);
        if (e < 8) { u.pm = 0; u.pn = e; u.kind = 1; u.A = memb; u.B = wmkv + (size_t)e * T; return true; }
        if (e < 16) { u.pm = e - 8; u.pn = 0; u.kind = 2; u.A = wmkv + (size_t)(8 + e - 8) * T; u.B = memb; return true; }
        return false;
    }
};

__device__ __forceinline__ void st8(bf16_t* p, f32x4 v0, f32x4 v1, float sc) {
    u32x4 w; w.x = cvtpk(v0[0] * sc, v0[1] * sc); w.y = cvtpk(v0[2] * sc, v0[3] * sc); w.z = cvtpk(v1[0] * sc, v1[1] * sc); w.w = cvtpk(v1[2] * sc, v1[3] * sc);
    *(u32x4*)p = w;
}
struct SchedMKV {
    const char* memb; const char* wmkv; int c;
    __device__ __forceinline__ bool next(int i, pg8::Unit& u) const {
        if (i > 0) return false;
        const int e = c & 15, kc = c >> 4; constexpr size_t T = (size_t)256 * DM * 2; const size_t ko = (size_t)kc * 1024;
        if (e < 8) { u.pm = 0; u.pn = e; u.kind = 1 | (kc << 2); u.A = memb + ko; u.B = wmkv + (size_t)e * T + ko; return true; }
        u.pm = 0; u.pn = e - 8; u.kind = 2 | (kc << 2); u.A = memb + ko; u.B = wmkv + (size_t)e * T + ko; return true;
    }
};
struct EpiMKV {
    float* part;
    __device__ __forceinline__ void operator()(const f32x4 (&acc)[2][2][4][2], const pg8::Unit& u, int wr, int wc, int fr, int fq) const {
        const int kc = u.kind >> 2, k = u.kind & 3; const int ldc = DM;
        float* P = part + (size_t)kc * (1u << 20) + (k == 1 ? 0 : MEM * DM);
        const int row0 = u.pm * 256 + wr * 64 + fr, col0 = u.pn * 256 + wc * 32 + 8 * fq;
#pragma unroll
        for (int ai = 0; ai < 2; ++ai)
#pragma unroll
            for (int m = 0; m < 4; ++m) { float* rowp = P + (size_t)(row0 + ai * 128 + m * 16) * ldc + col0;
#pragma unroll
                for (int bj = 0; bj < 2; ++bj) { *(f32x4*)(rowp + bj * 128) = acc[ai][bj][m][0]; *(f32x4*)(rowp + bj * 128 + 4) = acc[ai][bj][m][1]; } }
    }
};
__device__ __forceinline__ void mkv_reduce(const float* part, bf16_t* km, bf16_t* vmt, int gtid, int nthr) {
    for (int uidx = gtid; uidx < 131072; uidx += nthr) {
        const size_t off = (size_t)uidx * 8;
        bf16_t* dst = uidx < 65536 ? km + (size_t)uidx * 8 : vmt + (size_t)(uidx - 65536) * 8;
        const float* p = part + off;
        const f32x4 a0 = *(const f32x4*)p, a1 = *(const f32x4*)(p + 4), b0 = *(const f32x4*)(p + (1u << 20)), b1 = *(const f32x4*)(p + (1u << 20) + 4);
        const f32x4 c0 = *(const f32x4*)(p + (2u << 20)), c1 = *(const f32x4*)(p + (2u << 20) + 4), d0 = *(const f32x4*)(p + (3u << 20)), d1 = *(const f32x4*)(p + (3u << 20) + 4);
        st8(dst, (a0 + b0) + (c0 + d0), (a1 + b1) + (c1 + d1), 1.f);
    }
}
struct SchedMT {
    const char* km; const char* wmq; int c;
    __device__ __forceinline__ bool next(int i, pg8::Unit& u) const {
        if (i > 0) return false;
        const int h = c >> 3, pn = c & 7;
        u.pm = h; u.pn = pn; u.kind = 0; u.A = km + (size_t)h * 512 * 2; u.B = wmq + ((size_t)pn * 256 * DM + (size_t)h * 512) * 2; return true;
    }
};
struct EpiSoftmaxP {
    bf16_t* PB; LAS unsigned char* lds;
    __device__ __forceinline__ void operator()(const f32x4 (&acc)[2][2][4][2], const pg8::Unit& u, int wr, int wc, int fr, int fq) const {
        LAS float* pmax = (LAS float*)(lds + 131072); LAS float* psum = (LAS float*)(lds + 131072 + 4096);
        const int row0 = u.pm * 256 + wr * 64 + fr, col0 = u.pn * 256 + wc * 32 + 8 * fq;
        float mx[2][4], iv[2][4];
#pragma unroll
        for (int ai = 0; ai < 2; ++ai)
#pragma unroll
            for (int m = 0; m < 4; ++m) { float v = -1e30f;
#pragma unroll
                for (int bj = 0; bj < 2; ++bj)
#pragma unroll
                    for (int n = 0; n < 2; ++n) { const f32x4 t = acc[ai][bj][m][n]; v = fmaxf(v, fmaxf(fmaxf(t.x, t.y), fmaxf(t.z, t.w))); }
                v = fmaxf(v, lane_xor16(v)); v = fmaxf(v, lane_xor32(v));
                if (fq == 0) pmax[(wr * 4 + wc) * 128 + ai * 64 + m * 16 + fr] = v; }
        __syncthreads();
#pragma unroll
        for (int ai = 0; ai < 2; ++ai)
#pragma unroll
            for (int m = 0; m < 4; ++m) { const int li = ai * 64 + m * 16 + fr;
                const float v = fmaxf(fmaxf(pmax[(wr * 4 + 0) * 128 + li], pmax[(wr * 4 + 1) * 128 + li]), fmaxf(pmax[(wr * 4 + 2) * 128 + li], pmax[(wr * 4 + 3) * 128 + li]));
                mx[ai][m] = v; float sm = 0.f;
#pragma unroll
                for (int bj = 0; bj < 2; ++bj)
#pragma unroll
                    for (int n = 0; n < 2; ++n) { const f32x4 t = acc[ai][bj][m][n];
                        sm += (__builtin_amdgcn_exp2f(t.x - v) + __builtin_amdgcn_exp2f(t.y - v)) + (__builtin_amdgcn_exp2f(t.z - v) + __builtin_amdgcn_exp2f(t.w - v)); }
                sm += lane_xor16(sm); sm += lane_xor32(sm);
                if (fq == 0) psum[(wr * 4 + wc) * 128 + li] = sm; }
        __syncthreads();
#pragma unroll
        for (int ai = 0; ai < 2; ++ai)
#pragma unroll
            for (int m = 0; m < 4; ++m) { const int li = ai * 64 + m * 16 + fr;
                iv[ai][m] = 1.f / ((psum[(wr * 4 + 0) * 128 + li] + psum[(wr * 4 + 1) * 128 + li]) + (psum[(wr * 4 + 2) * 128 + li] + psum[(wr * 4 + 3) * 128 + li])); }
#pragma unroll
        for (int ai = 0; ai < 2; ++ai)
#pragma unroll
            for (int m = 0; m < 4; ++m) { bf16_t* rowp = PB + (size_t)(row0 + ai * 128 + m * 16) * 1024 + col0; const float v = mx[ai][m], inv = iv[ai][m];
#pragma unroll
                for (int bj = 0; bj < 2; ++bj) { const f32x4 t0 = acc[ai][bj][m][0], t1 = acc[ai][bj][m][1];
                    const f32x4 e0 = {__builtin_amdgcn_exp2f(t0.x - v), __builtin_amdgcn_exp2f(t0.y - v), __builtin_amdgcn_exp2f(t0.z - v), __builtin_amdgcn_exp2f(t0.w - v)};
                    const f32x4 e1 = {__builtin_amdgcn_exp2f(t1.x - v), __builtin_amdgcn_exp2f(t1.y - v), __builtin_amdgcn_exp2f(t1.z - v), __builtin_amdgcn_exp2f(t1.w - v)};
                    st8(rowp + bj * 128, e0, e1, inv); } }
    }
};
struct SchedVW {
    const char* wmot; const char* vm; int c;
    __device__ __forceinline__ bool next(int i, pg8::Unit& u) const {
        if (i > 0) return false;
        const int pm = c & 7, h = c >> 3;
        u.pm = pm; u.pn = h; u.kind = 0; u.A = wmot + ((size_t)pm * 256 * DM + (size_t)h * 512) * 2; u.B = vm + (size_t)h * 512 * 2; return true;
    }
};
struct EpiBf16 {
    bf16_t* O; int ldc; float scale;
    __device__ __forceinline__ void operator()(const f32x4 (&acc)[2][2][4][2], const pg8::Unit& u, int wr, int wc, int fr, int fq) const {
        const int row0 = u.pm * 256 + wr * 64 + fr, col0 = u.pn * 256 + wc * 32 + 8 * fq;
#pragma unroll
        for (int ai = 0; ai < 2; ++ai)
#pragma unroll
            for (int m = 0; m < 4; ++m) { bf16_t* rowp = O + (size_t)(row0 + ai * 128 + m * 16) * ldc + col0;
#pragma unroll
                for (int bj = 0; bj < 2; ++bj) st8(rowp + bj * 128, acc[ai][bj][m][0], acc[ai][bj][m][1], scale); }
    }
};
struct EpiP1 {
    bf16_t* proj; bf16_t* km; bf16_t* vmt; const f32x2* rope;
    __device__ __forceinline__ void operator()(const f32x4 (&acc)[2][2][4][2], const pg8::Unit& u, int wr, int wc, int fr, int fq) const {
        if (u.kind != 0) {
            const int row0 = u.pm * 256 + wr * 64 + fr, col0 = u.pn * 256 + wc * 32 + 8 * fq;
#pragma unroll
            for (int ai = 0; ai < 2; ++ai)
#pragma unroll
                for (int m = 0; m < 4; ++m) { const int row = row0 + ai * 128 + m * 16;
#pragma unroll
                    for (int bj = 0; bj < 2; ++bj) { const int col = col0 + bj * 128;
                        const int unit = u.kind == 1 ? ((((col >> 9) * 32 + ((col & 511) >> 4)) * 8 + (row >> 5)) * 64 + ((col >> 3) & 1) * 32 + (row & 31))
                                                     : (((((row >> 9) * 4 + ((row >> 7) & 3)) * 16 + (col >> 4)) * 4 + ((row >> 5) & 3)) * 64 + ((col >> 3) & 1) * 32 + (row & 31));
                        st8((u.kind == 1 ? km : vmt) + (size_t)unit * 8, acc[ai][bj][m][0], acc[ai][bj][m][1], 1.f); } }
            return;
        }
        const int sec = u.pn >> 2, colt = (u.pn & 3) * 256;
        const float sc = sec == 0 ? C_SB : (sec == 3 ? C_DF : 1.f);
        const bool dorope = (sec == 3 || sec == 4) && ((wc & 1) == 0);
        bf16_t* O = proj + (size_t)sec * PROJ_SEC;
        const int row0 = u.pm * 256 + wr * 64 + fr, col0 = colt + wc * 32 + 8 * fq;
#pragma unroll
        for (int ai = 0; ai < 2; ++ai)
#pragma unroll
            for (int m = 0; m < 4; ++m) { const int row = row0 + ai * 128 + m * 16; bf16_t* rowp = O + (size_t)row * 1024 + col0;
#pragma unroll
                for (int bj = 0; bj < 2; ++bj) {
                    f32x4 v0 = acc[ai][bj][m][0], v1 = acc[ai][bj][m][1];
                    if (dorope) {
                        f32x4 o0, o1;
#pragma unroll
                        for (int j = 0; j < 4; ++j) { o0[j] = lane_xor16(v0[j]); o1[j] = lane_xor16(v1[j]); }
                        if (fq < 2) {
                            const f32x2* rp = rope + (size_t)row * 8; const float sg = fq == 0 ? -1.f : 1.f;
#pragma unroll
                            for (int j = 0; j < 4; ++j) { const f32x2 c0 = rp[j], c1 = rp[4 + j];
                                v0[j] = v0[j] * c0.x + sg * o0[j] * c0.y; v1[j] = v1[j] * c1.x + sg * o1[j] * c1.y; }
                        }
                    }
                    st8(rowp + bj * 128, v0, v1, sc);
                } }
    }
};
template <bool RES_BF16> struct EpiRes {
    const void* res; bf16_t* Y;
    __device__ __forceinline__ void operator()(const f32x4 (&acc)[2][2][4][2], const pg8::Unit& u, int wr, int wc, int fr, int fq) const {
        const int row0 = u.pm * 256 + wr * 64 + fr, col0 = u.pn * 256 + wc * 32 + 8 * fq;
#pragma unroll
        for (int ai = 0; ai < 2; ++ai)
#pragma unroll
            for (int m = 0; m < 4; ++m) { const size_t off = (size_t)(row0 + ai * 128 + m * 16) * DM + col0;
#pragma unroll
                for (int bj = 0; bj < 2; ++bj) { f32x4 r0, r1;
                    if (RES_BF16) { const u32x4 w = *(const u32x4*)((const bf16_t*)res + off + bj * 128);
                        r0 = (f32x4){bflo(w.x), bfhi(w.x), bflo(w.y), bfhi(w.y)}; r1 = (f32x4){bflo(w.z), bfhi(w.z), bflo(w.w), bfhi(w.w)}; }
                    else { r0 = *(const f32x4*)((const float*)res + off + bj * 128); r1 = *(const f32x4*)((const float*)res + off + bj * 128 + 4); }
                    const f32x4 y0 = r0 * ALPHA + acc[ai][bj][m][0], y1 = r1 * ALPHA + acc[ai][bj][m][1];
                    *(u32x4*)(Y + off + bj * 128) = (u32x4){cvtpk(y0.x, y0.y), cvtpk(y0.z, y0.w), cvtpk(y1.x, y1.y), cvtpk(y1.z, y1.w)}; } }
    }
};

struct EpiResStats {
    const bf16_t* res; bf16_t* Y; f32x2* PS;
    __device__ __forceinline__ void operator()(const f32x4 (&acc)[2][2][4][2], const pg8::Unit& u, int wr, int wc, int fr, int fq) const {
        const int row0 = u.pm * 256 + wr * 64 + fr, col0 = u.pn * 256 + wc * 32 + 8 * fq;
#pragma unroll
        for (int ai = 0; ai < 2; ++ai)
#pragma unroll
            for (int m = 0; m < 4; ++m) { const int row = row0 + ai * 128 + m * 16; const size_t off = (size_t)row * DM + col0; float s1 = 0.f, s2 = 0.f;
#pragma unroll
                for (int bj = 0; bj < 2; ++bj) { const u32x4 w = *(const u32x4*)(res + off + bj * 128);
                    const f32x4 r0 = (f32x4){bflo(w.x), bfhi(w.x), bflo(w.y), bfhi(w.y)}, r1 = (f32x4){bflo(w.z), bfhi(w.z), bflo(w.w), bfhi(w.w)};
                    const f32x4 y0 = r0 * ALPHA + acc[ai][bj][m][0], y1 = r1 * ALPHA + acc[ai][bj][m][1];
                    s1 += ((y0.x + y0.y) + (y0.z + y0.w)) + ((y1.x + y1.y) + (y1.z + y1.w));
                    s2 += ((y0.x * y0.x + y0.y * y0.y) + (y0.z * y0.z + y0.w * y0.w)) + ((y1.x * y1.x + y1.y * y1.y) + (y1.z * y1.z + y1.w * y1.w));
                    *(u32x4*)(Y + off + bj * 128) = (u32x4){cvtpk(y0.x, y0.y), cvtpk(y0.z, y0.w), cvtpk(y1.x, y1.y), cvtpk(y1.z, y1.w)}; }
                s1 += lane_xor16(s1); s2 += lane_xor16(s2); s1 += lane_xor32(s1); s2 += lane_xor32(s2);
                if (fq == 0) PS[(size_t)row * 32 + u.pn * 4 + wc] = (f32x2){s1, s2}; }
    }
};
struct EpiPQ {
    bf16_t* O; const f32x2* PS; const f32x2* C12; f32x2* MR;
    __device__ __forceinline__ void operator()(const f32x4 (&acc)[2][2][4][2], const pg8::Unit& u, int wr, int wc, int fr, int fq) const {
        const int row0 = u.pm * 256 + wr * 64 + fr, col0 = u.pn * 256 + wc * 32 + 8 * fq;
        float rs[2][4], mr[2][4];
#pragma unroll
        for (int ai = 0; ai < 2; ++ai)
#pragma unroll
            for (int m = 0; m < 4; ++m) { const int row = row0 + ai * 128 + m * 16; const f32x4* pp = (const f32x4*)(PS + (size_t)row * 32 + fq * 8);
                const f32x4 p0 = pp[0], p1 = pp[1], p2 = pp[2], p3 = pp[3];
                float s1 = ((p0.x + p0.z) + (p1.x + p1.z)) + ((p2.x + p2.z) + (p3.x + p3.z)), s2 = ((p0.y + p0.w) + (p1.y + p1.w)) + ((p2.y + p2.w) + (p3.y + p3.w));
                s1 += lane_xor16(s1); s2 += lane_xor16(s2); s1 += lane_xor32(s1); s2 += lane_xor32(s2);
                const float mean = s1 * (1.f / DM); const float var = fmaxf(s2 * (1.f / DM) - mean * mean, 0.f); const float rstd = 1.f / sqrtf(var + LN_EPS);
                rs[ai][m] = rstd; mr[ai][m] = rstd * mean;
                if (u.pn == 0 && wc == 0 && fq == 0) MR[row] = (f32x2){mean, rstd}; }
#pragma unroll
        for (int bj = 0; bj < 2; ++bj) { const f32x4* cp = (const f32x4*)(C12 + col0 + bj * 128); const f32x4 c0 = cp[0], c1 = cp[1], c2 = cp[2], c3 = cp[3];
#pragma unroll
            for (int ai = 0; ai < 2; ++ai)
#pragma unroll
                for (int m = 0; m < 4; ++m) { const float r = rs[ai][m], q = mr[ai][m]; const f32x4 a0 = acc[ai][bj][m][0], a1 = acc[ai][bj][m][1];
                    const f32x4 v0 = {a0.x * r - q * c0.x + c0.y, a0.y * r - q * c0.z + c0.w, a0.z * r - q * c1.x + c1.y, a0.w * r - q * c1.z + c1.w};
                    const f32x4 v1 = {a1.x * r - q * c2.x + c2.y, a1.y * r - q * c2.z + c2.w, a1.z * r - q * c3.x + c3.y, a1.w * r - q * c3.z + c3.w};
                    st8(O + (size_t)(row0 + ai * 128 + m * 16) * DM + col0 + bj * 128, v0, v1, 1.f); } }
    }
};

__device__ __forceinline__ void p0_transpose_item(const float* W, int K, int N, bf16_t* WT, LAS float* scr, int item, int lane) {
    const int nblk = N / 32, kb = item / nblk, nb = item % nblk, k0 = 64 * kb, n0 = 32 * nb;
#pragma unroll
    for (int i = 0; i < 32; ++i) { const int kk = 2 * i + (lane >> 5); scr[kk * 33 + (lane & 31)] = __builtin_nontemporal_load(&W[(size_t)(k0 + kk) * N + n0 + (lane & 31)]); }
    LDS_WAIT(); asm volatile("" ::: "memory");
    const int c = lane & 7;
#pragma unroll
    for (int j = 0; j < 4; ++j) { const int n = (lane >> 3) + 8 * j; const LAS float* s = scr + (8 * c) * 33 + n;
        u32x4 o; o.x = pk2(s[0 * 33], s[1 * 33]); o.y = pk2(s[2 * 33], s[3 * 33]); o.z = pk2(s[4 * 33], s[5 * 33]); o.w = pk2(s[6 * 33], s[7 * 33]);
        *(u32x4*)(WT + (size_t)(n0 + n) * K + k0 + 8 * c) = o; }
    LDS_WAIT(); asm volatile("" ::: "memory");
}
__device__ __forceinline__ void cvt_row_bf16(const float* src, bf16_t* dst, int lane) {
#pragma unroll
    for (int m = 0; m < 8; ++m) { const f32x4 v = __builtin_nontemporal_load(&((const f32x4*)src)[64 * m + lane]); ((u32x2*)dst)[64 * m + lane] = (u32x2){pk2(v.x, v.y), pk2(v.z, v.w)}; }
}
__device__ __forceinline__ void pq_transpose_item(const float* W, const float* gam, const float* bet, bf16_t* WT, float* P1, float* P2, LAS float* scr, int item, int lane) {
    constexpr int K = DM, N = DM; const int nblk = N / 32, kb = item / nblk, nb = item % nblk, k0 = 64 * kb, n0 = 32 * nb;
    float c1 = 0.f, c2 = 0.f;
#pragma unroll
    for (int i = 0; i < 32; ++i) { const int kk = 2 * i + (lane >> 5); const float w = __builtin_nontemporal_load(&W[(size_t)(k0 + kk) * N + n0 + (lane & 31)]); const float wg = w * gam[k0 + kk];
        scr[kk * 33 + (lane & 31)] = wg; c1 += bitsf(f2bf(wg) << 16); c2 += w * bet[k0 + kk]; }
    c1 += lane_xor32(c1); c2 += lane_xor32(c2);
    if (lane < 32) { P1[(size_t)kb * N + n0 + lane] = c1; P2[(size_t)kb * N + n0 + lane] = c2; }
    LDS_WAIT(); asm volatile("" ::: "memory");
    const int c = lane & 7;
#pragma unroll
    for (int j = 0; j < 4; ++j) { const int n = (lane >> 3) + 8 * j; const LAS float* sp = scr + (8 * c) * 33 + n;
        u32x4 o; o.x = pk2(sp[0 * 33], sp[1 * 33]); o.y = pk2(sp[2 * 33], sp[3 * 33]); o.z = pk2(sp[4 * 33], sp[5 * 33]); o.w = pk2(sp[6 * 33], sp[7 * 33]);
        *(u32x4*)(WT + (size_t)(n0 + n) * K + k0 + 8 * c) = o; }
    LDS_WAIT(); asm volatile("" ::: "memory");
}
constexpr int EROW = 1152;
__device__ __forceinline__ unsigned fp4_code(float y) { const float a = fabsf(y);
    const unsigned idx = a < 0.25f ? 0u : (a < 0.75f ? 1u : (a < 1.25f ? 2u : (a < 1.75f ? 3u : (a < 2.5f ? 4u : (a < 3.5f ? 5u : (a < 5.f ? 6u : 7u))))));
    return idx | (y < 0.f ? 8u : 0u); }
__device__ __forceinline__ void cvt_row_expert(const float* src, unsigned char* dst, int lane) {
    f32x4 v[8]; float mx = 0.f;
#pragma unroll
    for (int m = 0; m < 8; ++m) { v[m] = __builtin_nontemporal_load(&((const f32x4*)src)[64 * m + lane]);
        mx = fmaxf(mx, fmaxf(fmaxf(fabsf(v[m].x), fabsf(v[m].y)), fmaxf(fabsf(v[m].z), fabsf(v[m].w)))); }
    const unsigned sb = f2bf(mx > 0.f ? mx * (1.f / 6.f) : 1.f); const float sc = bitsf(sb << 16); const float inv = 1.f / sc;
    u32x4 w;
#pragma unroll
    for (int d = 0; d < 4; ++d) { unsigned p = 0;
        p = __builtin_amdgcn_cvt_scalef32_pk_fp4_f32(p, v[2 * d][0] * inv, v[2 * d + 1][0] * inv, 1.0f, 0);
        p = __builtin_amdgcn_cvt_scalef32_pk_fp4_f32(p, v[2 * d][1] * inv, v[2 * d + 1][1] * inv, 1.0f, 1);
        p = __builtin_amdgcn_cvt_scalef32_pk_fp4_f32(p, v[2 * d][2] * inv, v[2 * d + 1][2] * inv, 1.0f, 2);
        p = __builtin_amdgcn_cvt_scalef32_pk_fp4_f32(p, v[2 * d][3] * inv, v[2 * d + 1][3] * inv, 1.0f, 3);
        w[d] = p; }
    __builtin_nontemporal_store(w, &((u32x4*)dst)[lane]);
    __builtin_nontemporal_store((unsigned short)sb, &((unsigned short*)(dst + 1024))[lane]);
}
__device__ __forceinline__ void cvt_expert_idx(const Args& a, int r, int lane) {
    if (r < NEXP) cvt_row_expert(a.in[16] + (size_t)r * DM, a.ws + WS_UT + (size_t)r * EROW, lane);
    else cvt_row_expert(a.in[17] + (size_t)(r - NEXP) * DM, a.ws + WS_VT + (size_t)(r - NEXP) * EROW, lane);
}
constexpr int NE_P0 = 2 * NEXP - 30720;
constexpr int NE_P4 = 1536;
constexpr int NE_T6 = 7168;
__device__ __forceinline__ void p0_prologue(const Args& a, LAS unsigned char* lds, int gw, int NGW, int wave, int lane) {
    unsigned char* ws = a.ws;
    LAS float* scr = (LAS float*)(lds + wave * 16384);
    constexpr int I_IN = 32 * (INW / 32), I_SQ = 32 * (DM / 32), I_KV = 32 * (4096 / 32);
    constexpr int T_END = I_IN + 4 * I_SQ + I_KV;
    constexpr int X_END = T_END + SEQ;
    constexpr int M_END = X_END + MEM;
    constexpr int K_END = M_END + 16;
    constexpr int E_END = K_END + 2 * NEXP;
    constexpr int R_END = E_END + 1024;
    for (int it = gw; it < R_END; it += NGW) {
        int r = it;
        if (r < T_END) {
            if (r < I_IN) { p0_transpose_item(a.in[2], DM, INW, (bf16_t*)(ws + WS_WIN), scr, r, lane); continue; } r -= I_IN;
            if (r < I_SQ) { continue; } r -= I_SQ;
            if (r < I_SQ) { continue; } r -= I_SQ;
            if (r < I_KV) { continue; } r -= I_KV;
            if (r < I_SQ) { continue; } r -= I_SQ;
            continue;
        }
        if (r < X_END) { r -= T_END; cvt_row_bf16(a.in[0] + (size_t)r * DM, (bf16_t*)(ws + WS_XB) + (size_t)r * DM, lane); continue; }
        if (r < M_END) { r -= X_END; cvt_row_bf16(a.in[1] + (size_t)r * DM, (bf16_t*)(ws + WS_MEMB) + (size_t)r * DM, lane); continue; }
        if (r < K_END) { r -= M_END; cvt_row_bf16(a.in[15] + (size_t)r * DM, (bf16_t*)(ws + WS_KEYS) + (size_t)r * DM, lane); continue; }
        if (r < E_END) { continue;
            r -= K_END; if (r >= NE_P0) continue;
            if (r < NEXP) cvt_row_expert(a.in[16] + (size_t)r * DM, ws + WS_UT + (size_t)r * EROW, lane);
            else { r -= NEXP; cvt_row_expert(a.in[17] + (size_t)r * DM, ws + WS_VT + (size_t)r * EROW, lane); }
            continue; }
        { r -= E_END; const int gid = r * 64 + lane, row = gid >> 3, i = gid & 7;
            const double fr_[8] = {0.15915494309189535, 0.03086376340470123, 0.005985185712713705, 0.001160663641240061,
                                   0.00022507907903927653, 4.364795279280289e-05, 8.464330808241401e-06, 1.6414262627950345e-06};
            double f = 0.0;
#pragma unroll
            for (int q = 0; q < 8; ++q) f = (i == q) ? fr_[q] : f;
            const double rev = (double)row * f; const float frac = (float)(rev - floor(rev));
            ((f32x2*)(ws + WS_ROPE))[gid] = (f32x2){__builtin_amdgcn_cosf(frac), __builtin_amdgcn_sinf(frac)}; }
    }
    if (gw == 0 && lane == 0) {
        const float* lf = a.in[4]; float s01 = 0.f, s23 = 0.f;
        for (int i = 0; i < 64; ++i) { s01 += lf[i] * lf[64 + i]; s23 += lf[128 + i] * lf[192 + i]; }
        ((float*)(ws + WS_CTL))[CW_LAM] = expf(s01) - expf(s23) + LAMBDA_INIT;
    }
}

__device__ __forceinline__ void p0_late(const Args& a, LAS unsigned char* lds, int gw, int NGW, int wave, int lane) {
    unsigned char* ws = a.ws; LAS float* scr = (LAS float*)(lds + wave * 16384);
    constexpr int I_SQ = 32 * (DM / 32), I_KV = 32 * (4096 / 32);
    for (int it = gw; it < 3 * I_SQ + I_KV; it += NGW) { int r = it;
        if (r < I_SQ) { p0_transpose_item(a.in[6], DM, DM, (bf16_t*)(ws + WS_WO), scr, r, lane); continue; } r -= I_SQ;
        if (r < I_KV) { p0_transpose_item(a.in[10], DM, 4096, (bf16_t*)(ws + WS_WMKV), scr, r, lane); continue; } r -= I_KV;
        if (r < I_SQ) { cvt_row_bf16(a.in[9] + (size_t)r * DM, (bf16_t*)(ws + WS_WMQ) + (size_t)r * DM, lane); continue; } r -= I_SQ;
        p0_transpose_item(a.in[11], DM, DM, (bf16_t*)(ws + WS_WMO), scr, r, lane); }
    for (int r = gw; r < NE_P0; r += NGW) cvt_expert_idx(a, r, lane);
}
__device__ __forceinline__ void ln_phase(const bf16_t* Y, bf16_t* X, const float* gain, const float* bias, int gw, int NGW, int lane) {
    f32x4 G0[4], G1[4], B0[4], B1[4];
#pragma unroll
    for (int j = 0; j < 4; ++j) { G0[j] = ((const f32x4*)gain)[128 * j + 2 * lane]; G1[j] = ((const f32x4*)gain)[128 * j + 2 * lane + 1]; B0[j] = ((const f32x4*)bias)[128 * j + 2 * lane]; B1[j] = ((const f32x4*)bias)[128 * j + 2 * lane + 1]; }
    for (int row = gw; row < SEQ; row += NGW) {
        const u32x4* yr = (const u32x4*)(Y + (size_t)row * DM) + lane;
        float v[4][8]; float s = 0.f;
#pragma unroll
        for (int j = 0; j < 4; ++j) { const u32x4 w = yr[64 * j];
            v[j][0] = bflo(w.x); v[j][1] = bfhi(w.x); v[j][2] = bflo(w.y); v[j][3] = bfhi(w.y); v[j][4] = bflo(w.z); v[j][5] = bfhi(w.z); v[j][6] = bflo(w.w); v[j][7] = bfhi(w.w);
            s += ((v[j][0] + v[j][1]) + (v[j][2] + v[j][3])) + ((v[j][4] + v[j][5]) + (v[j][6] + v[j][7])); }
        const float mean = wave_sum(s) * (1.f / DM); float s2 = 0.f;
#pragma unroll
        for (int j = 0; j < 4; ++j)
#pragma unroll
            for (int i = 0; i < 8; ++i) { v[j][i] -= mean; s2 += v[j][i] * v[j][i]; }
        const float rstd = 1.f / sqrtf(wave_sum(s2) * (1.f / DM) + LN_EPS);
        u32x4* o = (u32x4*)(X + (size_t)row * DM) + lane;
#pragma unroll
        for (int j = 0; j < 4; ++j) { const f32x4 g0 = G0[j], g1 = G1[j], b0 = B0[j], b1 = B1[j];
            o[64 * j] = (u32x4){pk2(v[j][0] * rstd * g0.x + b0.x, v[j][1] * rstd * g0.y + b0.y), pk2(v[j][2] * rstd * g0.z + b0.z, v[j][3] * rstd * g0.w + b0.w),
                                pk2(v[j][4] * rstd * g1.x + b1.x, v[j][5] * rstd * g1.y + b1.y), pk2(v[j][6] * rstd * g1.z + b1.z, v[j][7] * rstd * g1.w + b1.w)}; }
    }
}

__device__ __forceinline__ void attn_naive_phase(const Args& a, LAS unsigned char* lds, int gw, int NGW, int wave, int lane) {
    unsigned char* ws = a.ws;
    const bf16_t* proj = (const bf16_t*)(ws + WS_PROJ);
    const bf16_t* SBQ = proj, * SBK = proj + PROJ_SEC, * SBV = proj + 2 * PROJ_SEC, * DQ = proj + 3 * PROJ_SEC, * DK = proj + 4 * PROJ_SEC, * DV = proj + 5 * PROJ_SEC;
    bf16_t* MIX = (bf16_t*)(ws + WS_MIX);
    LAS float* qs = (LAS float*)(lds + wave * 1024);
    LAS float* wsm = (LAS float*)(lds + wave * 1024 + 512);
    const float lam = ((const float*)(ws + WS_CTL))[CW_LAM];
    for (int it = gw; it < SEQ * 16; it += NGW) {
        const int t = it >> 4, u = it & 15;
        if (u < 8) {
            const int h = u;
            { const unsigned w = *(const unsigned*)(SBQ + (size_t)t * 1024 + h * 128 + 2 * lane); qs[2 * lane] = bflo(w); qs[2 * lane + 1] = bfhi(w); }
            LDS_WAIT();
            float acc0 = 0.f, acc1 = 0.f, R = 0.f;
            for (int c0 = t - 1; c0 >= 0; c0 -= 64) {
                const int s = c0 - lane; const bool valid = s >= 0;
                float z = 0.f;
                if (valid) { const u32x4* kp = (const u32x4*)(SBK + (size_t)s * 1024 + h * 128);
                    for (int d = 0; d < 16; ++d) { const u32x4 kw = kp[d]; const LAS float* q8 = qs + 8 * d;
                        z += bflo(kw.x) * q8[0] + bfhi(kw.x) * q8[1] + bflo(kw.y) * q8[2] + bfhi(kw.y) * q8[3] + bflo(kw.z) * q8[4] + bfhi(kw.z) * q8[5] + bflo(kw.w) * q8[6] + bfhi(kw.w) * q8[7]; } }
                z = fminf(fmaxf(z, -126.f), 126.f);
                const float e = __builtin_amdgcn_exp2f(-z), l2 = __builtin_amdgcn_logf(1.f + e);
                const float lk = valid ? (-z - l2) : 0.f;
                float incl = lk;
#pragma unroll
                for (int off = 1; off < 64; off <<= 1) { const float tt = __shfl_up(incl, off); if (lane >= off) incl += tt; }
                const float w = valid ? __builtin_amdgcn_exp2f(R + (incl - lk) - l2) : 0.f;
                R += __shfl(incl, 63);
                wsm[lane] = w; LDS_WAIT();
                const int nk = c0 + 1 < 64 ? c0 + 1 : 64;
                for (int j = 0; j < nk; ++j) { const float wj = wsm[j]; const unsigned vw = *(const unsigned*)(SBV + (size_t)(c0 - j) * 1024 + h * 128 + 2 * lane);
                    acc0 += wj * bflo(vw); acc1 += wj * bfhi(vw); }
                LDS_WAIT();
            }
            const float ss = wave_sum(acc0 * acc0 + acc1 * acc1);
            const float rstd = 1.f / sqrtf(ss * (1.f / 128.f) + RMS_EPS);
            const float* g = a.in[3] + h * 128 + 2 * lane;
            *(unsigned*)(MIX + (size_t)t * DM + h * 128 + 2 * lane) = pk2(acc0 * rstd * g[0], acc1 * rstd * g[1]);
        } else {
            const int h = u - 8;
            { const unsigned w = *(const unsigned*)(DQ + (size_t)t * 1024 + h * 128 + 2 * lane); qs[2 * lane] = bflo(w); qs[2 * lane + 1] = bfhi(w); }
            LDS_WAIT();
            float r0[2], r1[2];
            for (int mp = 0; mp < 2; ++mp) {
                float acc0 = 0.f, acc1 = 0.f, m = -1e30f, l = 0.f;
                for (int c0 = 0; c0 <= t; c0 += 64) {
                    const int s = c0 + lane; const bool valid = s <= t;
                    float z = -__builtin_inff();
                    if (valid) { z = 0.f; const u32x4* kp = (const u32x4*)(DK + (size_t)s * 1024 + h * 128 + mp * 64);
                        for (int d = 0; d < 8; ++d) { const u32x4 kw = kp[d]; const LAS float* q8 = qs + mp * 64 + 8 * d;
                            z += bflo(kw.x) * q8[0] + bfhi(kw.x) * q8[1] + bflo(kw.y) * q8[2] + bfhi(kw.y) * q8[3] + bflo(kw.z) * q8[4] + bfhi(kw.z) * q8[5] + bflo(kw.w) * q8[6] + bfhi(kw.w) * q8[7]; } }
                    const float mn = fmaxf(m, wave_max(z)); const float al = __builtin_amdgcn_exp2f(m - mn); m = mn;
                    const float p = valid ? __builtin_amdgcn_exp2f(z - mn) : 0.f;
                    l = l * al + wave_sum(p); acc0 *= al; acc1 *= al;
                    wsm[lane] = p; LDS_WAIT();
                    const int nk = t - c0 + 1 < 64 ? t - c0 + 1 : 64;
                    for (int j = 0; j < nk; ++j) { const float wj = wsm[j]; const unsigned vw = *(const unsigned*)(DV + (size_t)(c0 + j) * 1024 + h * 128 + 2 * lane);
                        acc0 += wj * bflo(vw); acc1 += wj * bfhi(vw); }
                    LDS_WAIT();
                }
                r0[mp] = acc0 / l; r1[mp] = acc1 / l;
            }
            const float o0 = r0[0] - lam * r0[1], o1 = r1[0] - lam * r1[1];
            const float ss = wave_sum(o0 * o0 + o1 * o1);
            const float rstd = (1.f - LAMBDA_INIT) / sqrtf(ss * (1.f / 128.f) + RMS_EPS);
            const float* g = a.in[5] + 2 * lane;
            *(unsigned*)(MIX + (size_t)t * DM + 1024 + h * 128 + 2 * lane) = pk2(o0 * rstd * g[0], o1 * rstd * g[1]);
        }
    }
}


namespace fa {
constexpr int SHM_V = 64 * 128 * 2, SHM_K = 64 * 128 * 2;
constexpr float SB_STOP = -64.f;
#define FA_KSWZ(row, colB) ((row) * 256 + ((colB) ^ (((row) & 7) << 4)))
#define FA_SBAR() __builtin_amdgcn_sched_barrier(0)
__device__ __forceinline__ int v_st(int k, int c) { const int kk = (k & ~0xC) | ((k & 4) << 1) | ((k & 8) >> 1); return ((kk >> 3) * 4 + (c >> 5)) * 512 + ((kk & 7) * 32 + (c & 31)) * 2; }
__device__ __forceinline__ int v_rd_base(int lane) { return ((lane & 3) << 3) | (((lane >> 2) & 3) << 6) | (((lane >> 4) & 1) << 5) | (((lane >> 5) & 1) << 8); }
constexpr int v_rd_off(int d0, int ks, int half) { return d0 * 512 + ks * 4096 + half * 2048; }
template <int D0, int NK>
__device__ __forceinline__ void qkt(f32x16& p0, f32x16& p1, const char* Kb, int r32, int hi, const bf16x8* qr) {
    p0 = f32x16{}; p1 = f32x16{};
#pragma unroll
    for (int d = 0; d < NK; ++d) { const int cb = ((D0 + d) * 16 + hi * 8) * 2;
        const bf16x8 b0 = *reinterpret_cast<const bf16x8*>(Kb + FA_KSWZ(r32, cb));
        const bf16x8 b1 = *reinterpret_cast<const bf16x8*>(Kb + FA_KSWZ(32 + r32, cb));
        p0 = __builtin_amdgcn_mfma_f32_32x32x16_bf16(b0, qr[d], p0, 0, 0, 0);
        p1 = __builtin_amdgcn_mfma_f32_32x32x16_bf16(b1, qr[d], p1, 0, 0, 0); }
}
__device__ __forceinline__ void qkt_lq(f32x16& p0, f32x16& p1, const char* Kb, const char* Qw, int r32, int hi) {
    p0 = f32x16{}; p1 = f32x16{};
#pragma unroll
    for (int d = 0; d < 8; ++d) { const int cb = (d * 16 + hi * 8) * 2;
        const bf16x8 q = *reinterpret_cast<const bf16x8*>(Qw + FA_KSWZ(r32, cb));
        const bf16x8 b0 = *reinterpret_cast<const bf16x8*>(Kb + FA_KSWZ(r32, cb));
        const bf16x8 b1 = *reinterpret_cast<const bf16x8*>(Kb + FA_KSWZ(32 + r32, cb));
        p0 = __builtin_amdgcn_mfma_f32_32x32x16_bf16(b0, q, p0, 0, 0, 0);
        p1 = __builtin_amdgcn_mfma_f32_32x32x16_bf16(b1, q, p1, 0, 0, 0); }
}
__device__ __forceinline__ void pv_tile(f32x16* o, int vb0, bf16x8 pa0, bf16x8 pa1, bf16x8 pa2, bf16x8 pa3) {
#define FA_TRRD(dst, off) asm volatile("ds_read_b64_tr_b16 %0, %1 offset:%2" : "=&v"(dst) : "v"(vb0), "i"(off) : "memory")
#define FA_PV_RD(P_, d0) do { constexpr int b_ = v_rd_off(d0, 0, 0); \
        FA_TRRD(P_##l0, b_); FA_TRRD(P_##h0, b_ + 2048); FA_TRRD(P_##l1, b_ + 4096); FA_TRRD(P_##h1, b_ + 6144); FA_TRRD(P_##l2, b_ + 8192); FA_TRRD(P_##h2, b_ + 10240); FA_TRRD(P_##l3, b_ + 12288); FA_TRRD(P_##h3, b_ + 14336); } while (0)
#define FA_PV_MM(P_, d0) do { \
        o[d0] = __builtin_amdgcn_mfma_f32_32x32x16_bf16(pa0, (bf16x8){P_##l0[0], P_##l0[1], P_##l0[2], P_##l0[3], P_##h0[0], P_##h0[1], P_##h0[2], P_##h0[3]}, o[d0], 0, 0, 0); \
        o[d0] = __builtin_amdgcn_mfma_f32_32x32x16_bf16(pa1, (bf16x8){P_##l1[0], P_##l1[1], P_##l1[2], P_##l1[3], P_##h1[0], P_##h1[1], P_##h1[2], P_##h1[3]}, o[d0], 0, 0, 0); \
        o[d0] = __builtin_amdgcn_mfma_f32_32x32x16_bf16(pa2, (bf16x8){P_##l2[0], P_##l2[1], P_##l2[2], P_##l2[3], P_##h2[0], P_##h2[1], P_##h2[2], P_##h2[3]}, o[d0], 0, 0, 0); \
        o[d0] = __builtin_amdgcn_mfma_f32_32x32x16_bf16(pa3, (bf16x8){P_##l3[0], P_##l3[1], P_##l3[2], P_##l3[3], P_##h3[0], P_##h3[1], P_##h3[2], P_##h3[3]}, o[d0], 0, 0, 0); } while (0)
#define FA_PV_WAIT(n) do { asm volatile("s_waitcnt lgkmcnt(" #n ")" ::: "memory"); FA_SBAR(); } while (0)
    s16x4 Al0, Al1, Al2, Al3, Ah0, Ah1, Ah2, Ah3, Bl0, Bl1, Bl2, Bl3, Bh0, Bh1, Bh2, Bh3;
    FA_PV_RD(A, 0);
    FA_PV_RD(B, 1); FA_PV_WAIT(8); FA_PV_MM(A, 0); FA_SBAR();
    FA_PV_RD(A, 2); FA_PV_WAIT(8); FA_PV_MM(B, 1); FA_SBAR();
    FA_PV_RD(B, 3); FA_PV_WAIT(8); FA_PV_MM(A, 2); FA_SBAR();
    FA_PV_WAIT(0); FA_PV_MM(B, 3);
#undef FA_PV_RD
#undef FA_PV_MM
#undef FA_PV_WAIT
#undef FA_TRRD
}
__device__ __forceinline__ void pv_tile_s(f32x16* o, int vb0, bf16x8 pa0, bf16x8 pa1, bf16x8 pa2, bf16x8 pa3) {
#define FA_TRRD(dst, off) asm volatile("ds_read_b64_tr_b16 %0, %1 offset:%2" : "=&v"(dst) : "v"(vb0), "i"(off) : "memory")
#define FA_PV_D0(d0) do { s16x4 l0, l1, l2, l3, h0, h1, h2, h3; constexpr int b_ = v_rd_off(d0, 0, 0); \
        FA_TRRD(l0, b_); FA_TRRD(h0, b_ + 2048); FA_TRRD(l1, b_ + 4096); FA_TRRD(h1, b_ + 6144); FA_TRRD(l2, b_ + 8192); FA_TRRD(h2, b_ + 10240); FA_TRRD(l3, b_ + 12288); FA_TRRD(h3, b_ + 14336); \
        asm volatile("s_waitcnt lgkmcnt(0)" ::: "memory"); FA_SBAR(); \
        o[d0] = __builtin_amdgcn_mfma_f32_32x32x16_bf16(pa0, (bf16x8){l0[0], l0[1], l0[2], l0[3], h0[0], h0[1], h0[2], h0[3]}, o[d0], 0, 0, 0); \
        o[d0] = __builtin_amdgcn_mfma_f32_32x32x16_bf16(pa1, (bf16x8){l1[0], l1[1], l1[2], l1[3], h1[0], h1[1], h1[2], h1[3]}, o[d0], 0, 0, 0); \
        o[d0] = __builtin_amdgcn_mfma_f32_32x32x16_bf16(pa2, (bf16x8){l2[0], l2[1], l2[2], l2[3], h2[0], h2[1], h2[2], h2[3]}, o[d0], 0, 0, 0); \
        o[d0] = __builtin_amdgcn_mfma_f32_32x32x16_bf16(pa3, (bf16x8){l3[0], l3[1], l3[2], l3[3], h3[0], h3[1], h3[2], h3[3]}, o[d0], 0, 0, 0); } while (0)
    FA_PV_D0(0); FA_PV_D0(1); FA_PV_D0(2); FA_PV_D0(3);
#undef FA_PV_D0
#undef FA_TRRD
}
#define FA_PVK_TRRD(dst, off) asm volatile("ds_read_b64_tr_b16 %0, %1 offset:%2" : "=&v"(dst) : "v"(vbk_), "i"(off) : "memory")
#define FA_PVK_RD(S_, ks) do { FA_PVK_TRRD(S_##l0, v_rd_off(0, ks, 0)); FA_PVK_TRRD(S_##h0, v_rd_off(0, ks, 1)); FA_PVK_TRRD(S_##l1, v_rd_off(1, ks, 0)); FA_PVK_TRRD(S_##h1, v_rd_off(1, ks, 1)); \
        FA_PVK_TRRD(S_##l2, v_rd_off(2, ks, 0)); FA_PVK_TRRD(S_##h2, v_rd_off(2, ks, 1)); FA_PVK_TRRD(S_##l3, v_rd_off(3, ks, 0)); FA_PVK_TRRD(S_##h3, v_rd_off(3, ks, 1)); } while (0)
#define FA_PVK_MM(S_, pa_) do { \
        o[0] = __builtin_amdgcn_mfma_f32_32x32x16_bf16(pa_, (bf16x8){S_##l0[0], S_##l0[1], S_##l0[2], S_##l0[3], S_##h0[0], S_##h0[1], S_##h0[2], S_##h0[3]}, o[0], 0, 0, 0); \
        o[1] = __builtin_amdgcn_mfma_f32_32x32x16_bf16(pa_, (bf16x8){S_##l1[0], S_##l1[1], S_##l1[2], S_##l1[3], S_##h1[0], S_##h1[1], S_##h1[2], S_##h1[3]}, o[1], 0, 0, 0); \
        o[2] = __builtin_amdgcn_mfma_f32_32x32x16_bf16(pa_, (bf16x8){S_##l2[0], S_##l2[1], S_##l2[2], S_##l2[3], S_##h2[0], S_##h2[1], S_##h2[2], S_##h2[3]}, o[2], 0, 0, 0); \
        o[3] = __builtin_amdgcn_mfma_f32_32x32x16_bf16(pa_, (bf16x8){S_##l3[0], S_##l3[1], S_##l3[2], S_##l3[3], S_##h3[0], S_##h3[1], S_##h3[2], S_##h3[3]}, o[3], 0, 0, 0); } while (0)
#define FA_PVK_W(n) do { asm volatile("s_waitcnt lgkmcnt(" #n ")" ::: "memory"); FA_SBAR(); } while (0)
#define FA_PVK(VB, P0, P1) do { const int vbk_ = (VB); s16x4 Al0, Al1, Al2, Al3, Ah0, Ah1, Ah2, Ah3, Bl0, Bl1, Bl2, Bl3, Bh0, Bh1, Bh2, Bh3; bf16x8 pq0_, pq1_; \
        FA_PVK_RD(A, 0); FA_PK4(P0, 0, pq0_); FA_SBAR(); \
        FA_PVK_RD(B, 1); FA_PVK_W(8); FA_PVK_MM(A, pq0_); FA_SBAR(); FA_PK4(P0, 8, pq1_); FA_SBAR(); \
        FA_PVK_RD(A, 2); FA_PVK_W(8); FA_PVK_MM(B, pq1_); FA_SBAR(); FA_PK4(P1, 0, pq0_); FA_SBAR(); \
        FA_PVK_RD(B, 3); FA_PVK_W(8); FA_PVK_MM(A, pq0_); FA_SBAR(); FA_PK4(P1, 8, pq1_); FA_SBAR(); \
        FA_PVK_W(0); FA_PVK_MM(B, pq1_); } while (0)
#define FA_PK4(P, B_, OUT) do { unsigned a0 = cvtpk(P[B_ + 0], P[B_ + 1]), a1 = cvtpk(P[B_ + 2], P[B_ + 3]); \
        unsigned b0 = cvtpk(P[B_ + 4], P[B_ + 5]), b1 = cvtpk(P[B_ + 6], P[B_ + 7]); \
        auto r0 = __builtin_amdgcn_permlane32_swap(a0, b0, false, false); auto r1 = __builtin_amdgcn_permlane32_swap(a1, b1, false, false); \
        u32x4 w_ = {r0[0], r1[0], r0[1], r1[1]}; OUT = __builtin_bit_cast(bf16x8, w_); } while (0)
#define FA_PKB(P, S_, OUT) do { u32x4 w_ = {cvtpk(P[8 * S_ + 0], P[8 * S_ + 1]), cvtpk(P[8 * S_ + 2], P[8 * S_ + 3]), cvtpk(P[8 * S_ + 4], P[8 * S_ + 5]), cvtpk(P[8 * S_ + 6], P[8 * S_ + 7])}; OUT = __builtin_bit_cast(bf16x8, w_); } while (0)
__device__ __forceinline__ float half_bcast(float v) {
    float v2 = v; asm volatile("" : "+v"(v2)); auto rr = __builtin_amdgcn_permlane32_swap(fbits(v), fbits(v2), false, false);
    const unsigned r0_ = rr[0], r1_ = rr[1]; (void)r1_; return bitsf(r0_);
}
__device__ __forceinline__ float half_other(float v) {
    float v2 = v; asm volatile("" : "+v"(v2));
    auto rr = __builtin_amdgcn_permlane32_swap(fbits(v), fbits(v2), false, false);
    const unsigned r0_ = rr[0], r1_ = rr[1];
    return (threadIdx.x & 32) ? bitsf(r1_) : bitsf(r0_);
}
__device__ __forceinline__ float half_max(float v) { float v2 = v; asm volatile("" : "+v"(v2)); auto rr = __builtin_amdgcn_permlane32_swap(fbits(v), fbits(v2), false, false);
    const unsigned r0_ = rr[0], r1_ = rr[1]; return fmaxf(bitsf(r0_), bitsf(r1_)); }
__device__ __forceinline__ float half_add(float v) { float v2 = v; asm volatile("" : "+v"(v2)); auto rr = __builtin_amdgcn_permlane32_swap(fbits(v), fbits(v2), false, false);
    const unsigned r0_ = rr[0], r1_ = rr[1]; return bitsf(r0_) + bitsf(r1_); }

struct Stg { bf16x8 v0, v1, k0, k1; };
#define FA_SLOAD(S, Kp, Vp, kb) do { S.v0 = *(const bf16x8*)(Vp + (size_t)((kb) + sr) * 1024 + sc); S.v1 = *(const bf16x8*)(Vp + (size_t)((kb) + 32 + sr) * 1024 + sc); \
        S.k0 = *(const bf16x8*)(Kp + (size_t)((kb) + sr) * 1024 + sc); S.k1 = *(const bf16x8*)(Kp + (size_t)((kb) + 32 + sr) * 1024 + sc); } while (0)
#define FA_SWRITE(S, bf) do { *(bf16x8*)(V_lds + (bf) * SHM_V + vst0) = S.v0; *(bf16x8*)(V_lds + (bf) * SHM_V + vst1) = S.v1; \
        *(bf16x8*)(K_lds + (bf) * SHM_K + kws) = S.k0; *(bf16x8*)(K_lds + (bf) * SHM_K + kws + 32 * 256) = S.k1; } while (0)

__device__ __forceinline__ void sb_unit(const bf16_t* SBQ, const bf16_t* SBK, const bf16_t* SBV, bf16_t* MIX, const float* gain, int h, int qb, char* lds) {
    int tid_o = threadIdx.x; asm volatile("" : "+v"(tid_o));
    const int tid = tid_o, wid = __builtin_amdgcn_readfirstlane(tid >> 6), lane = tid & 63, r32 = lane & 31, hi = lane >> 5;
    char* V_lds = lds; char* K_lds = lds + 2 * SHM_V;
    const int q0 = qb * 256, qrow = q0 + wid * 32 + r32;
    const bf16_t* Kp = SBK + h * 128; const bf16_t* Vp = SBV + h * 128;
    const int sr = tid >> 4, sc = (tid & 15) * 8, vst0 = v_st(sr, sc), vst1 = v_st(32 + sr, sc), kws = FA_KSWZ(sr, sc * 2);
    const int vb0 = (int)(uintptr_t)V_lds + v_rd_base(lane);
    bf16x8 qr[8];
#pragma unroll
    for (int d0 = 0; d0 < 8; ++d0) qr[d0] = *(const bf16x8*)(SBQ + (size_t)qrow * 1024 + h * 128 + d0 * 16 + hi * 8);
    bf16x8 tpa0, tpa1, ones;
    { u32x4 t0, t1;
#pragma unroll
      for (int i = 0; i < 4; ++i) { unsigned w0 = 0, w1 = 0;
#pragma unroll
          for (int e = 0; e < 2; ++e) { const int j = 2 * i + e; const int rho0 = 8 * (j >> 2) + 4 * hi + (j & 3), rho1 = 16 + rho0;
              w0 |= (rho0 > r32 ? 0x3F80u : 0u) << (16 * e); w1 |= (rho1 > r32 ? 0x3F80u : 0u) << (16 * e); }
          t0[i] = w0; t1[i] = w1; }
      tpa0 = __builtin_bit_cast(bf16x8, t0); tpa1 = __builtin_bit_cast(bf16x8, t1);
      const u32x4 o1 = {0x3F803F80u, 0x3F803F80u, 0x3F803F80u, 0x3F803F80u}; ones = __builtin_bit_cast(bf16x8, o1); }
    f32x16 o[4];
#pragma unroll
    for (int d = 0; d < 4; ++d) o[d] = f32x16{};
    float R = 0.f;
    const int NT = 4 * qb + 4, jmax = 4 * qb + (wid >> 1);
    Stg S;
    volatile int* dfl = (volatile int*)(lds + 2 * SHM_V + 2 * SHM_K + 1024);
    bool alldone = false;
    FA_SLOAD(S, Kp, Vp, (NT - 1) * 64); FA_SWRITE(S, 0); __syncthreads();
#define FA_SB_STEP(it, BUF) do { const int j = NT - 1 - (it); \
        if ((it) + 1 < NT) FA_SLOAD(S, Kp, Vp, (j - 1) * 64); \
        if (j <= jmax) { \
            f32x16 p0, p1; qkt<0, 8>(p0, p1, K_lds + (BUF) * SHM_K, r32, hi, qr); \
            const bool msk = (j == jmax); const int dq = qrow - 64 * j - 4 * hi;       \
            bf16x8 L0a, L0b, L1a, L1b; float rfix; \
            { f32x16 lk1; \
              _Pragma("unroll") for (int r = 0; r < 16; ++r) { const int c = (r & 3) + 8 * (r >> 2); \
                const float z = __builtin_amdgcn_fmed3f(p1[r], -126.f, 126.f); const float e = __builtin_amdgcn_exp2f(-z); const float l2 = __builtin_amdgcn_logf(1.f + e); float lk = -z - l2; if (msk && !(c + 32 < dq)) lk = 0.f; lk1[r] = lk; p1[r] = R - l2; } \
              FA_PKB(lk1, 0, L1a); FA_PKB(lk1, 1, L1b); } \
            { f32x16 lk0; \
              _Pragma("unroll") for (int r = 0; r < 16; ++r) { const int c = (r & 3) + 8 * (r >> 2); \
                const float z = __builtin_amdgcn_fmed3f(p0[r], -126.f, 126.f); const float e = __builtin_amdgcn_exp2f(-z); const float l2 = __builtin_amdgcn_logf(1.f + e); float lk = -z - l2; if (msk && !(c < dq)) lk = 0.f; lk0[r] = lk; p0[r] = R - l2; } \
              rfix = lk0[0] - p0[0];                                  \
              FA_PKB(lk0, 0, L0a); FA_PKB(lk0, 1, L0b); } \
            p0 = __builtin_amdgcn_mfma_f32_32x32x16_bf16(tpa0, L0a, p0, 0, 0, 0); p0 = __builtin_amdgcn_mfma_f32_32x32x16_bf16(tpa1, L0b, p0, 0, 0, 0); \
            p0 = __builtin_amdgcn_mfma_f32_32x32x16_bf16(ones, L1a, p0, 0, 0, 0); p0 = __builtin_amdgcn_mfma_f32_32x32x16_bf16(ones, L1b, p0, 0, 0, 0); \
            p1 = __builtin_amdgcn_mfma_f32_32x32x16_bf16(tpa0, L1a, p1, 0, 0, 0); p1 = __builtin_amdgcn_mfma_f32_32x32x16_bf16(tpa1, L1b, p1, 0, 0, 0); \
            const float rn = p0[0] + rfix + R;                        \
            _Pragma("unroll") for (int r = 0; r < 16; ++r) { const int c = (r & 3) + 8 * (r >> 2); \
                float w0 = __builtin_amdgcn_exp2f(p0[r]); if (msk && !(c < dq)) w0 = 0.f; p0[r] = w0; \
                float w1 = __builtin_amdgcn_exp2f(p1[r]); if (msk && !(c + 32 < dq)) w1 = 0.f; p1[r] = w1; } \
            R = half_bcast(rn); \
            bf16x8 pa0, pa1, pa2, pa3; FA_PK4(p0, 0, pa0); FA_PK4(p0, 8, pa1); FA_PK4(p1, 0, pa2); FA_PK4(p1, 8, pa3); \
            pv_tile(o, vb0 + (BUF) * SHM_V, pa0, pa1, pa2, pa3); \
        } \
        { const bool wdone = (j <= jmax) && __all(R < SB_STOP); if (lane == 0) dfl[(BUF) * 8 + wid] = wdone ? 1 : 0; } \
        if ((it) + 1 < NT) FA_SWRITE(S, (BUF) ^ 1); \
        __syncthreads(); \
        { int c_ = 0; _Pragma("unroll") for (int w_ = 0; w_ < 8; ++w_) c_ += dfl[(BUF) * 8 + w_]; alldone = (c_ == 8); } } while (0)
#pragma unroll 1
    for (int it = 0; it < NT; it += 2) { FA_SB_STEP(it, 0); if (alldone) break; FA_SB_STEP(it + 1, 1); if (alldone) break; }
#undef FA_SB_STEP
    float ss[16];
#pragma unroll
    for (int r = 0; r < 16; ++r) { float v = o[0][r] * o[0][r] + o[1][r] * o[1][r] + o[2][r] * o[2][r] + o[3][r] * o[3][r];
        v = half32_sum(v);
        ss[r] = 1.f / sqrtf(v * (1.f / 128.f) + RMS_EPS); }
    float gn[4];
#pragma unroll
    for (int d0 = 0; d0 < 4; ++d0) gn[d0] = gain[h * 128 + d0 * 32 + r32];
    bf16_t* Ow = MIX + (size_t)(q0 + wid * 32) * DM + h * 128;
#pragma unroll
    for (int r = 0; r < 16; ++r) { const int orow = crow(r, hi);
#pragma unroll
        for (int d0 = 0; d0 < 4; ++d0) { const float v = o[d0][r] * ss[r] * gn[d0]; const float vn = dpp_xor1(v);
            if ((r32 & 1) == 0) *(unsigned*)(Ow + (size_t)orow * DM + d0 * 32 + r32) = cvtpk(v, vn); } }
    __syncthreads();
}

__device__ __forceinline__ void df_unit(const bf16_t* DQ, const bf16_t* DK, const bf16_t* DV, bf16_t* MIX, const float* gain, float lam, int h, int qb, char* lds) {
    int tid_o = threadIdx.x; asm volatile("" : "+v"(tid_o));
    const int tid = tid_o, wid = __builtin_amdgcn_readfirstlane(tid >> 6), lane = tid & 63, r32 = lane & 31, hi = lane >> 5;
    const int mp = wid >> 2, qw = wid & 3;
    char* V_lds = lds; char* K_lds = lds + 2 * SHM_V;
    float* wsf = (float*)(lds + 2 * SHM_V + 2 * SHM_K) + wid * 64; float* li_l = wsf; float* al_l = wsf + 32;
    const int q0 = qb * 128, qrow = q0 + qw * 32 + r32;
    const bf16_t* Kp = DK + h * 128; const bf16_t* Vp = DV + h * 128;
    const int sr = tid >> 4, sc = (tid & 15) * 8, vst0 = v_st(sr, sc), vst1 = v_st(32 + sr, sc), kws = FA_KSWZ(sr, sc * 2);
    const int vb0 = (int)(uintptr_t)V_lds + v_rd_base(lane);
    const int NT = 2 * qb + 2, jmax = 2 * qb + (qw >> 1);
    bf16x8 qr[4];
#pragma unroll
    for (int d0 = 0; d0 < 4; ++d0) qr[d0] = *(const bf16x8*)(DQ + (size_t)qrow * 1024 + h * 128 + mp * 64 + d0 * 16 + hi * 8);
    f32x16 o[4];
#pragma unroll
    for (int d = 0; d < 4; ++d) o[d] = f32x16{};
    float m_reg = -1e30f, l_reg = 0.f;
    Stg S0;
    f32x16 pA0, pA1, pB0, pB1; float alA = 1.f, alB = 1.f;
    const int kq = mp * 128;
#define DF_QKT(P0, P1, BUF) do { const char* Kb_ = K_lds + (BUF) * SHM_K; P0 = f32x16{}; P1 = f32x16{}; \
        _Pragma("unroll") for (int d = 0; d < 4; ++d) { const int cb = kq + (d * 16 + hi * 8) * 2; \
            const bf16x8 b0 = *reinterpret_cast<const bf16x8*>(Kb_ + FA_KSWZ(r32, cb)); const bf16x8 b1 = *reinterpret_cast<const bf16x8*>(Kb_ + FA_KSWZ(32 + r32, cb)); \
            P0 = __builtin_amdgcn_mfma_f32_32x32x16_bf16(b0, qr[d], P0, 0, 0, 0); P1 = __builtin_amdgcn_mfma_f32_32x32x16_bf16(b1, qr[d], P1, 0, 0, 0); } } while (0)
#define DF_PSM(P0, P1, AL) do { \
        float pmax = P0[0]; \
        _Pragma("unroll") for (int r = 1; r < 16; ++r) pmax = fmaxf(pmax, P0[r]); \
        _Pragma("unroll") for (int r = 0; r < 16; ++r) pmax = fmaxf(pmax, P1[r]); \
        pmax = half_max(pmax); float mn; \
        if (__all(pmax - m_reg <= 8.f)) { mn = m_reg; AL = 1.f; } else { mn = fmaxf(m_reg, pmax); AL = __builtin_amdgcn_exp2f(m_reg - mn); m_reg = mn; } \
        _Pragma("unroll") for (int r = 0; r < 16; ++r) { P0[r] -= mn; P1[r] -= mn; } \
        _Pragma("unroll") for (int r = 0; r < 16; ++r) P0[r] = __builtin_amdgcn_exp2f(P0[r]); } while (0)
#define DF_MASK(P0, P1, J) do { const int dq = qrow - 64 * (J) - 4 * hi; const float NEG = -__builtin_inff(); \
        _Pragma("unroll") for (int r = 0; r < 16; ++r) { const int c = (r & 3) + 8 * (r >> 2); if (c > dq) P0[r] = NEG; if (c + 32 > dq) P1[r] = NEG; } } while (0)
#define DF_FSM(P0, P1, AL) do { \
        _Pragma("unroll") for (int r = 0; r < 16; ++r) P1[r] = __builtin_amdgcn_exp2f(P1[r]); \
        float ps = 0.f; \
        _Pragma("unroll") for (int r = 0; r < 16; ++r) ps += P0[r]; \
        _Pragma("unroll") for (int r = 0; r < 16; ++r) ps += P1[r]; \
        ps = half_add(ps); l_reg = l_reg * (AL) + ps; } while (0)
#define DF_RESC(AL) do { if (__any((AL) < 1.f)) { if (hi == 0) al_l[r32] = (AL); asm volatile("s_waitcnt lgkmcnt(0)" ::: "memory"); \
        _Pragma("unroll") for (int r = 0; r < 16; ++r) { const float al = al_l[crow(r, hi)]; o[0][r] *= al; o[1][r] *= al; o[2][r] *= al; o[3][r] *= al; } } } while (0)
#define DF_PV_PSM(VB, Y0, Y1, X0, X1, AL) do { const int vbk_ = (VB); s16x4 Al0, Al1, Al2, Al3, Ah0, Ah1, Ah2, Ah3, Bl0, Bl1, Bl2, Bl3, Bh0, Bh1, Bh2, Bh3; bf16x8 pq0_, pq1_; float pmax_, mn_; \
        FA_PVK_RD(A, 0); FA_PK4(Y0, 0, pq0_); FA_SBAR(); \
        FA_PVK_RD(B, 1); FA_PVK_W(8); FA_PVK_MM(A, pq0_); \
        pmax_ = X0[0]; _Pragma("unroll") for (int r = 1; r < 16; ++r) pmax_ = fmaxf(pmax_, X0[r]); \
        FA_PK4(Y0, 8, pq1_); FA_SBAR(); \
        FA_PVK_RD(A, 2); FA_PVK_W(8); FA_PVK_MM(B, pq1_); \
        _Pragma("unroll") for (int r = 0; r < 16; ++r) pmax_ = fmaxf(pmax_, X1[r]); \
        pmax_ = half_max(pmax_); \
        { const bool ok_ = __all(pmax_ - m_reg <= 8.f); mn_ = ok_ ? m_reg : fmaxf(m_reg, pmax_); AL = __builtin_amdgcn_exp2f(m_reg - mn_); m_reg = mn_; } \
        FA_PK4(Y1, 0, pq0_); FA_SBAR(); \
        FA_PVK_RD(B, 3); FA_PVK_W(8); FA_PVK_MM(A, pq0_); \
        _Pragma("unroll") for (int r = 0; r < 16; ++r) { X0[r] -= mn_; X1[r] -= mn_; } \
        FA_PK4(Y1, 8, pq1_); FA_SBAR(); \
        FA_PVK_W(0); FA_PVK_MM(B, pq1_); \
        _Pragma("unroll") for (int r = 0; r < 16; ++r) X0[r] = __builtin_amdgcn_exp2f(X0[r]); } while (0)
#define DF_STEP_U(J, X0, X1, ALX, Y0, Y1, ALY, BX, SLD, SWR) do { \
        FA_SBAR(); DF_QKT(X0, X1, BX); DF_FSM(Y0, Y1, ALY); FA_SBAR(); \
        FA_SLOAD(S0, Kp, Vp, ((J) + 1) * 64); FA_SBAR(); \
        DF_PV_PSM(vb0 + ((BX) ^ 1) * SHM_V, Y0, Y1, X0, X1, ALX); \
        __syncthreads(); FA_SWRITE(S0, (BX) ^ 1); \
        DF_RESC(ALX); __syncthreads(); } while (0)
#define DF_STEP_G(J, X0, X1, ALX, Y0, Y1, ALY, BX, SLD, SWR) do { const int j_ = (J); const bool hx = j_ < NT && j_ <= jmax, hy = j_ >= 1 && j_ - 1 <= jmax; \
        FA_SBAR(); if (hx) DF_QKT(X0, X1, BX); if (hy) DF_FSM(Y0, Y1, ALY); FA_SBAR(); \
        if (j_ + 1 < NT) FA_SLOAD(S0, Kp, Vp, (j_ + 1) * 64); FA_SBAR(); \
        if (hy) FA_PVK(vb0 + ((BX) ^ 1) * SHM_V, Y0, Y1); \
        ALX = 1.f; if (hx) { if (j_ == jmax) DF_MASK(X0, X1, j_); DF_PSM(X0, X1, ALX); } \
        __syncthreads(); if (j_ + 1 < NT) FA_SWRITE(S0, (BX) ^ 1); \
        DF_RESC(ALX); __syncthreads(); } while (0)
    FA_SLOAD(S0, Kp, Vp, 0); FA_SWRITE(S0, 0); __syncthreads();
    DF_STEP_G(0, pA0, pA1, alA, pB0, pB1, alB, 0, S0, S1);
    int j = 1;
#pragma unroll 1
    for (; j + 1 <= NT - 3; j += 2) {
        DF_STEP_U(j, pB0, pB1, alB, pA0, pA1, alA, 1, S1, S0);
        DF_STEP_U(j + 1, pA0, pA1, alA, pB0, pB1, alB, 0, S0, S1);
    }
#pragma unroll 1
    for (; j <= NT; j += 2) {
        DF_STEP_G(j, pB0, pB1, alB, pA0, pA1, alA, 1, S1, S0);
        if (j + 1 <= NT) DF_STEP_G(j + 1, pA0, pA1, alA, pB0, pB1, alB, 0, S0, S1);
    }
#undef DF_QKT
#undef DF_PSM
#undef DF_MASK
#undef DF_FSM
#undef DF_RESC
#undef DF_STEP_U
#undef DF_PV_PSM
#undef DF_STEP_G
    if (hi == 0) li_l[r32] = l_reg; asm volatile("s_waitcnt lgkmcnt(0)" ::: "memory");
#pragma unroll
    for (int r = 0; r < 16; ++r) { const float il = 1.f / li_l[crow(r, hi)]; o[0][r] *= il; o[1][r] *= il; o[2][r] *= il; o[3][r] *= il; }
    float* ex = (float*)lds + qw * 4096 + lane;
    if (mp == 1) {
#pragma unroll
        for (int d = 0; d < 4; ++d)
#pragma unroll
            for (int r = 0; r < 16; ++r) ex[(d * 16 + r) * 64] = o[d][r];
    }
    __syncthreads();
    if (mp == 0) {
#pragma unroll
        for (int d = 0; d < 4; ++d)
#pragma unroll
            for (int r = 0; r < 16; ++r) o[d][r] -= lam * ex[(d * 16 + r) * 64];
        float ss[16];
#pragma unroll
        for (int r = 0; r < 16; ++r) { float v = o[0][r] * o[0][r] + o[1][r] * o[1][r] + o[2][r] * o[2][r] + o[3][r] * o[3][r];
            v = half32_sum(v);
            ss[r] = (1.f - LAMBDA_INIT) / sqrtf(v * (1.f / 128.f) + RMS_EPS); }
        float gn[4];
#pragma unroll
        for (int d0 = 0; d0 < 4; ++d0) gn[d0] = gain[d0 * 32 + r32];
        bf16_t* Ow = MIX + (size_t)(q0 + qw * 32) * DM + 1024 + h * 128;
#pragma unroll
        for (int r = 0; r < 16; ++r) { const int orow = crow(r, hi);
#pragma unroll
            for (int d0 = 0; d0 < 4; ++d0) { const float v = o[d0][r] * ss[r] * gn[d0]; const float vn = dpp_xor1(v);
                if ((r32 & 1) == 0) *(unsigned*)(Ow + (size_t)orow * DM + d0 * 32 + r32) = cvtpk(v, vn); } }
    }
    __syncthreads();
}
#undef FA_SLOAD
#undef FA_SWRITE
}

#ifndef REP_DF
#define REP_DF 1
#endif
#ifndef REP_SB
#define REP_SB 1
#endif
__device__ __forceinline__ void attn_fast_phase(const Args& a, LAS unsigned char* lds_las, bf16_t* MIXo, int blk, int G) {
    unsigned char* ws = a.ws; char* lds = (char*)lds_las;
    const bf16_t* proj = (const bf16_t*)(ws + WS_PROJ);
    const float lam = ((const float*)(ws + WS_CTL))[CW_LAM];
    for (int item = blk; item < 256; item += G) {
        const int h = item & 7, p = item >> 3;
#pragma unroll 1
        for (int pass = 0; pass < 2 * REP_DF; ++pass) fa::df_unit(proj + 3 * PROJ_SEC, proj + 4 * PROJ_SEC, proj + 5 * PROJ_SEC, MIXo, a.in[5], lam, h, (pass & 1) == 0 ? 63 - p : p, lds);
#pragma unroll 1
        for (int rep = 0; rep < REP_SB; ++rep)
        fa::sb_unit(proj, proj + PROJ_SEC, proj + 2 * PROJ_SEC, MIXo, a.in[3], h, p, lds);
    }
}

__device__ __forceinline__ void xattn_naive_phase(const Args& a, LAS unsigned char* lds, int gw, int NGW, int wave, int lane) {
    unsigned char* ws = a.ws;
    const bf16_t* QM = (const bf16_t*)(ws + WS_QM); const bf16_t* KM = (const bf16_t*)(ws + WS_KM); const bf16_t* VMT = (const bf16_t*)(ws + WS_VMT);
    bf16_t* OM = (bf16_t*)(ws + WS_OM);
    LAS float* qs = (LAS float*)(lds + wave * 4096);
    LAS float* ps = (LAS float*)(lds + wave * 4096 + 2048);
    for (int it = gw; it < SEQ * 4; it += NGW) {
        const int t = it >> 2, h = it & 3;
        { const u32x4 w = *(const u32x4*)(QM + (size_t)t * DM + h * 512 + 8 * lane); LAS float* q = qs + 8 * lane;
          q[0] = bflo(w.x); q[1] = bfhi(w.x); q[2] = bflo(w.y); q[3] = bfhi(w.y); q[4] = bflo(w.z); q[5] = bfhi(w.z); q[6] = bflo(w.w); q[7] = bfhi(w.w); }
        LDS_WAIT();
        float sc[4]; float mx = -1e30f;
        for (int i = 0; i < 4; ++i) { const int key = lane + 64 * i; const u32x4* kp = (const u32x4*)(KM + (size_t)key * DM + h * 512); float z = 0.f;
            for (int d = 0; d < 64; ++d) { const u32x4 kw = kp[d]; const LAS float* q8 = qs + 8 * d;
                z += bflo(kw.x) * q8[0] + bfhi(kw.x) * q8[1] + bflo(kw.y) * q8[2] + bfhi(kw.y) * q8[3] + bflo(kw.z) * q8[4] + bfhi(kw.z) * q8[5] + bflo(kw.w) * q8[6] + bfhi(kw.w) * q8[7]; }
            sc[i] = z; mx = fmaxf(mx, z); }
        mx = wave_max(mx); float sum = 0.f;
        for (int i = 0; i < 4; ++i) { sc[i] = __builtin_amdgcn_exp2f(sc[i] - mx); sum += sc[i]; }
        sum = wave_sum(sum); const float inv = 1.f / sum;
        for (int i = 0; i < 4; ++i) ps[lane + 64 * i] = sc[i] * inv;
        LDS_WAIT();
        float acc[8];
        for (int e = 0; e < 8; ++e) { const u32x4* vp = (const u32x4*)(VMT + (size_t)(h * 512 + 8 * lane + e) * MEM); float s = 0.f;
            for (int k8 = 0; k8 < 32; ++k8) { const u32x4 vw = vp[k8]; const LAS float* p8 = ps + 8 * k8;
                s += bflo(vw.x) * p8[0] + bfhi(vw.x) * p8[1] + bflo(vw.y) * p8[2] + bfhi(vw.y) * p8[3] + bflo(vw.z) * p8[4] + bfhi(vw.z) * p8[5] + bflo(vw.w) * p8[6] + bfhi(vw.w) * p8[7]; }
            acc[e] = s; }
        *(u32x4*)(OM + (size_t)t * DM + h * 512 + 8 * lane) = (u32x4){pk2(acc[0], acc[1]), pk2(acc[2], acc[3]), pk2(acc[4], acc[5]), pk2(acc[6], acc[7])};
        LDS_WAIT();
    }
}


__device__ __forceinline__ void xattn_fast_phase(const Args& a, LAS unsigned char* lds, int gw, int NGW, int lane) {
    unsigned char* ws = a.ws;
    const bf16_t* QM = (const bf16_t*)(ws + WS_QM); const bf16_t* KM = (const bf16_t*)(ws + WS_KM); const bf16_t* VMT = (const bf16_t*)(ws + WS_VMT);
    bf16_t* PB = (bf16_t*)(ws + WS_OM);
    const int r32 = lane & 31, hi = lane >> 5;
    const int blk_ = gw >> 3, wv_ = gw & 7, nblk_ = NGW >> 3;
#define XA_BAR() do { __builtin_amdgcn_sched_barrier(0); asm volatile("s_waitcnt lgkmcnt(0)\n\ts_barrier" ::: "memory"); __builtin_amdgcn_sched_barrier(0); } while (0)
#pragma unroll 1
    for (int ub = blk_; ub < 256; ub += nblk_) {
        const int h = ub & 3;
        if (wv_ >= 4) {
            const int tl = (wv_ - 4) * 64 + lane;
            u32x4 R[8];
            { const u32x4* src = (const u32x4*)(KM + (size_t)h * 131072) + tl;
#pragma unroll
              for (int i = 0; i < 8; ++i) R[i] = src[i * 256]; }
#pragma unroll 1
            for (int c = 0; c < 8; ++c) {
                LAS u32x4* dst = (LAS u32x4*)(lds + (c & 1) * 32768) + tl;
#pragma unroll
                for (int i = 0; i < 8; ++i) dst[i * 256] = R[i];
                if (c + 1 < 8) { const int cn = c + 1; const u32x4* src = (const u32x4*)(KM + (size_t)h * 131072 + (size_t)cn * 16384) + tl;
#pragma unroll
                    for (int i = 0; i < 8; ++i) R[i] = src[i * 256]; }
                XA_BAR();
            }
            continue;
        }
        const int qb = (ub >> 2) * 4 + wv_;
        f32x16 s[8];
#pragma unroll
        for (int t = 0; t < 8; ++t) s[t] = f32x16{};
        const bf16_t* qp = QM + (size_t)(qb * 32 + r32) * DM + h * 512 + 8 * hi;
        bf16x8 qn[4];
#pragma unroll
        for (int kk = 0; kk < 4; ++kk) qn[kk] = *(const bf16x8*)(qp + 16 * kk);
#pragma unroll 1
        for (int c = 0; c < 8; ++c) {
            bf16x8 qc[4];
#pragma unroll
            for (int kk = 0; kk < 4; ++kk) qc[kk] = qn[kk];
            if (c + 1 < 8) {
#pragma unroll
                for (int kk = 0; kk < 4; ++kk) qn[kk] = *(const bf16x8*)(qp + 16 * (4 * (c + 1) + kk)); }
            XA_BAR();
            const LAS bf16x8* kf = (const LAS bf16x8*)(lds + (c & 1) * 32768) + lane;
#pragma unroll
            for (int kk = 0; kk < 4; ++kk)
#pragma unroll
                for (int t = 0; t < 8; ++t) { const bf16x8 ak = kf[(kk * 8 + t) * 64]; s[t] = __builtin_amdgcn_mfma_f32_32x32x16_bf16(ak, qc[kk], s[t], 0, 0, 0); }
        }
        float mx = -1e30f;
#pragma unroll
        for (int t = 0; t < 8; ++t)
#pragma unroll
            for (int r = 0; r < 16; ++r) mx = fmaxf(mx, s[t][r]);
        mx = fmaxf(mx, __shfl_xor(mx, 32));
        float sum = 0.f;
#pragma unroll
        for (int t = 0; t < 8; ++t)
#pragma unroll
            for (int r = 0; r < 16; ++r) { const float e = __builtin_amdgcn_exp2f(s[t][r] - mx); s[t][r] = e; sum += e; }
        sum += __shfl_xor(sum, 32);
        const float inv = 1.f / sum;
        bf16x8 pa[16];
#pragma unroll
        for (int t = 0; t < 8; ++t) {
#pragma unroll
            for (int r = 0; r < 16; ++r) s[t][r] *= inv;
            FA_PK4(s[t], 0, pa[2 * t]); FA_PK4(s[t], 8, pa[2 * t + 1]); }
        { bf16_t* Pw = PB + (size_t)(qb * 32 + r32) * 1024 + h * 256 + 8 * hi;
#pragma unroll
          for (int ks = 0; ks < 16; ++ks) *(bf16x8*)(Pw + 16 * ks) = pa[ks]; }
    }
#undef XA_BAR
}
__device__ __forceinline__ float erf_f32(float z) {
    const float ax = fabsf(z), t = __builtin_amdgcn_rcpf(1.f + 0.3275911f * ax);
    const float poly = ((((1.061405429f * t - 1.453152027f) * t + 1.421413741f) * t - 0.284496736f) * t + 0.254829592f) * t;
    const float r = 1.f - poly * __builtin_amdgcn_exp2f(-ax * ax * LOG2E);
    return __builtin_copysignf(r, z);
}
__device__ __forceinline__ float max3f(float a, float b, float c) { return fmaxf(fmaxf(a, b), c); }
__device__ __forceinline__ void cex_desc(float& a, float& b) { const float mx = fmaxf(a, b), mn = fminf(a, b); a = mx; b = mn; }
__device__ __forceinline__ void sort16_desc(float* v) {
#pragma unroll
    for (int k = 2; k <= 16; k <<= 1)
#pragma unroll
        for (int j = k >> 1; j > 0; j >>= 1)
#pragma unroll
            for (int i = 0; i < 16; ++i) { const int l = i ^ j; if (l > i) { if ((i & k) == 0) cex_desc(v[i], v[l]); else cex_desc(v[l], v[i]); } }
}
__device__ __forceinline__ void merge_top16(float* a, const float* b) {
#pragma unroll
    for (int i = 0; i < 16; ++i) a[i] = fmaxf(a[i], b[15 - i]);
#pragma unroll
    for (int j = 8; j > 0; j >>= 1)
#pragma unroll
        for (int i = 0; i < 16; ++i) { const int l = i ^ j; if (l > i) cex_desc(a[i], a[l]); }
}

__device__ __forceinline__ int fresh_lane() { unsigned m_ = ~0u; asm volatile("" : "+s"(m_));
    int l_ = (int)__builtin_amdgcn_mbcnt_hi(m_, __builtin_amdgcn_mbcnt_lo(m_, 0u)); asm volatile("" : "+v"(l_)); return l_; }
__device__ __forceinline__ void peer_phase(const Args& a, LAS unsigned char* lds, int blk, int nblk, int wave, int lane) {
    unsigned char* ws = a.ws;
    const bf16_t* QP = (const bf16_t*)(ws + WS_QP); const bf16_t* KEYS = (const bf16_t*)(ws + WS_KEYS); const bf16_t* X2 = (const bf16_t*)(ws + WS_Y);
    const unsigned char* UT = ws + WS_UT; const unsigned char* VT = ws + WS_VT;
    constexpr int PEER_WLDS = 8192 + 256 + 4096;
    LAS int* idxs = (LAS int*)(lds + wave * PEER_WLDS);
    LAS float* gts = (LAS float*)(lds + wave * PEER_WLDS + 2048);
    LAS float* tops = (LAS float*)(lds + wave * PEER_WLDS + 4096);
    const float NEG = -__builtin_inff();
    LAS f32x4* gb = (LAS f32x4*)(lds + NWAVES * PEER_WLDS);
    { const int tid_ = wave * 64 + lane; gb[tid_] = ((const f32x4*)a.in[12])[tid_]; gb[512 + tid_] = ((const f32x4*)a.in[13])[tid_]; gb[1024 + tid_] = ((const f32x4*)a.in[18])[tid_]; gb[1536 + tid_] = ((const f32x4*)a.in[19])[tid_]; }
    __syncthreads();
    for (int tb = blk; tb < SEQ / 32; tb += nblk) {
        const int t0 = tb * 32 + wave * 4;
        int lane_o = fresh_lane(); asm volatile("" : "+v"(lane_o));
        const int row = lane_o & 31, hi = lane_o >> 5, tl_r = row >> 3, h_r = row & 7;
#ifndef PEER_PARTS
#define PEER_PARTS 7
#endif
        if (PEER_PARTS & 1)
#pragma unroll 1
        for (int c = 0; c < 2; ++c) {
            f32x16 s[4];
#pragma unroll
            for (int nt = 0; nt < 4; ++nt) s[nt] = f32x16{};
            const bf16_t* qp = QP + (size_t)(t0 + tl_r) * DM + h_r * 256 + c * 128 + 8 * hi;
            const bf16_t* kp = KEYS + (size_t)c * 128 * 128 + (size_t)row * 128 + 8 * hi;
            bf16x8 qA, kA[4], qB, kB[4];
#define PEER_SLD(Q, K, ks) do { Q = *(const bf16x8*)(qp + 16 * (ks)); _Pragma("unroll") for (int nt = 0; nt < 4; ++nt) K[nt] = *(const bf16x8*)(kp + (size_t)nt * 32 * 128 + 16 * (ks)); } while (0)
#define PEER_SMM(Q, K) do { _Pragma("unroll") for (int nt = 0; nt < 4; ++nt) s[nt] = __builtin_amdgcn_mfma_f32_32x32x16_bf16(K[nt], Q, s[nt], 0, 0, 0); } while (0)
#define PEER_SB() __builtin_amdgcn_sched_barrier(0)
            PEER_SLD(qA, kA, 0); PEER_SLD(qB, kB, 1); PEER_SB();
            PEER_SMM(qA, kA); PEER_SB(); PEER_SLD(qA, kA, 2); PEER_SB();
            PEER_SMM(qB, kB); PEER_SB(); PEER_SLD(qB, kB, 3); PEER_SB();
            PEER_SMM(qA, kA); PEER_SB(); PEER_SLD(qA, kA, 4); PEER_SB();
            PEER_SMM(qB, kB); PEER_SB(); PEER_SLD(qB, kB, 5); PEER_SB();
            PEER_SMM(qA, kA); PEER_SB(); PEER_SLD(qA, kA, 6); PEER_SB();
            PEER_SMM(qB, kB); PEER_SB(); PEER_SLD(qB, kB, 7); PEER_SB();
            PEER_SMM(qA, kA); PEER_SB();
            PEER_SMM(qB, kB); PEER_SB();
#undef PEER_SLD
#undef PEER_SMM
#undef PEER_SB
#if defined(PEER_DBG_CMP)
            { float* dbg = (float*)(ws + WS_Y) + (size_t)(blk * NWAVES + wave) * 8192 + c * 4096;
              _Pragma("unroll") for (int nt = 0; nt < 4; ++nt) _Pragma("unroll") for (int r = 0; r < 16; ++r) dbg[(32 * nt + crow(r, hi)) * 32 + row] = s[nt][r]; }
#endif
            float sp[64];
#pragma unroll
            for (int nt = 0; nt < 4; ++nt)
#pragma unroll
                for (int r = 0; r < 16; ++r) { const float sv_ = s[nt][r]; const unsigned ub = (fbits(sv_) & ~127u) | (unsigned)(32 * nt + crow(r, hi)); sp[nt * 16 + r] = bitsf(ub); }
            sort16_desc(sp); sort16_desc(sp + 16); sort16_desc(sp + 32); sort16_desc(sp + 48);
            merge_top16(sp, sp + 16); merge_top16(sp + 32, sp + 48); merge_top16(sp, sp + 32);
            float Lo[16], Hi[16];
#pragma unroll
            for (int i = 0; i < 16; ++i) { float m2 = sp[i]; asm volatile("" : "+v"(m2));
                auto rr = __builtin_amdgcn_permlane32_swap(fbits(sp[i]), fbits(m2), false, false);
                const unsigned r0_ = rr[0], r1_ = rr[1]; Lo[i] = bitsf(r0_); Hi[i] = bitsf(r1_); }
            merge_top16(Lo, Hi);
            if (hi == 0) {
#pragma unroll
                for (int k = 0; k < 16; ++k) tops[(c * 16 + k) * 32 + row] = Lo[k]; }
        }
        LDS_WAIT();
        if (PEER_PARTS & 2) {
            int lane_s = fresh_lane(); asm volatile("" : "+v"(lane_s));
            const int row = lane_s & 31, hi = lane_s >> 5, tl_r = row >> 3, h_r = row & 7;
            float v1[16], v2[16];
#pragma unroll
            for (int k = 0; k < 16; ++k) { v1[k] = tops[k * 32 + row]; v2[k] = tops[(16 + k) * 32 + row]; }
            float cv[64];
            { int n = 0;
#pragma unroll
              for (int aa = 0; aa < 16; ++aa)
#pragma unroll
                  for (int bb = 0; bb < 16; ++bb) if ((aa + 1) * (bb + 1) <= 16) {
                      const float sum = v1[aa] + v2[bb];
                      cv[n] = bitsf((fbits(sum) & ~255u) | (unsigned)(aa << 4 | bb));
                      ++n; }
#pragma unroll
              for (int i = 50; i < 64; ++i) cv[i] = NEG; }
            sort16_desc(cv); sort16_desc(cv + 16); sort16_desc(cv + 32); sort16_desc(cv + 48);
            merge_top16(cv, cv + 16); merge_top16(cv + 32, cv + 48); merge_top16(cv, cv + 32);
            float topv[16];
#pragma unroll
            for (int k = 0; k < 16; ++k) { topv[k] = cv[k];
                const unsigned tg = fbits(cv[k]) & 255u; const int aa = (int)(tg >> 4), bb = (int)(tg & 15u);
                const unsigned i1 = fbits(tops[aa * 32 + row]) & 127u, i2 = fbits(tops[(16 + bb) * 32 + row]) & 127u;
                if (hi == 0) idxs[tl_r * 128 + h_r * 16 + k] = (int)((i1 << 7) | i2); }
            float sum = 0.f; const float top0 = topv[0];
#pragma unroll
            for (int k = 0; k < 16; ++k) { topv[k] = __builtin_amdgcn_exp2f((topv[k] - top0) * LOG2E); sum += topv[k]; }
            const float inv = 1.f / sum;
            if (hi == 0) {
#pragma unroll
                for (int k = 0; k < 16; ++k) gts[tl_r * 128 + h_r * 16 + k] = topv[k] * inv;
            }
        }
        LDS_WAIT();
#if defined(PEER_DBG_CMP)
        LAS int* idxs_f = (LAS int*)(lds + 70000 + wave * 8192);
        LAS float* gts_f = (LAS float*)(lds + 70000 + wave * 8192 + 2048);
        LAS float* tops_f = (LAS float*)(lds + 70000 + wave * 8192 + 4096);
        for (int i = lane; i < 512; i += 64) { idxs_f[i] = idxs[i]; gts_f[i] = gts[i]; }
        for (int i = lane; i < 1024; i += 64) tops_f[i] = tops[i];
        LDS_WAIT();
        int mm1 = 0, mm2 = 0, mmg = 0, mm3 = 0; VM_WAIT();
#endif
#if defined(PEER_SLOW_SELECT)
        {
            LAS float* vs = tops;
            LAS int* is = (LAS int*)(tops + 64);
            _Pragma("unroll 1") for (int rr = 0; rr < 32; ++rr) {
                const int t = t0 + (rr >> 3), h = rr & 7;
                _Pragma("unroll 1") for (int c = 0; c < 2; ++c) {
                    float v0 = 0.f, v1 = 0.f;
                    const bf16_t* qrow = QP + (size_t)t * DM + h * 256 + c * 128;
                    const float* k0 = a.in[15] + (size_t)c * 128 * 128 + (size_t)lane * 128; const float* k1 = k0 + 64 * 128;
                    _Pragma("unroll 1") for (int d = 0; d < 128; ++d) { const float q = bf1(qrow[d]); v0 += q * k0[d]; v1 += q * k1[d]; }
#if defined(PEER_DBG_CMP)
                    { const float* dbg = (const float*)(ws + WS_Y) + (size_t)(blk * NWAVES + wave) * 8192 + c * 4096;
                      if (fabsf(dbg[lane * 32 + rr] - v0) > 0.05f) ++mm3; if (fabsf(dbg[(lane + 64) * 32 + rr] - v1) > 0.05f) ++mm3; }
#endif
                    _Pragma("unroll 1") for (int k = 0; k < 16; ++k) {
                        const float m = wave_max(fmaxf(v0, v1));
                        const bool i0 = v0 == m, i1 = v1 == m;
                        const unsigned long long bal = __ballot(i0 || i1);
                        const int src = __ffsll((long long)bal) - 1;
                        const int myidx = i0 ? lane : lane + 64;
                        const int idx = __shfl(myidx, src);
                        if (lane == src) { if (i0) v0 = NEG; else v1 = NEG; }
                        if (lane == 0) { vs[c * 16 + k] = m; is[c * 16 + k] = idx; }
                    }
                }
                LDS_WAIT();
#if defined(PEER_DBG_CMP)
                if (lane < 32) { const int c_ = lane >> 4, k_ = lane & 15; const int fi = (int)(__builtin_bit_cast(unsigned, tops_f[(c_ * 16 + k_) * 32 + rr]) & 127u); if (fi != is[c_ * 16 + k_]) ++mm1; }
#endif
                float cvv[4]; int cii[4];
                _Pragma("unroll") for (int i = 0; i < 4; ++i) { const int j = lane + 64 * i, aa = j >> 4, bb = j & 15; cvv[i] = vs[aa] + vs[16 + bb]; cii[i] = is[aa] * 128 + is[16 + bb]; }
                float tv[16];
                _Pragma("unroll") for (int k = 0; k < 16; ++k) {
                    const float m = wave_max(fmaxf(fmaxf(cvv[0], cvv[1]), fmaxf(cvv[2], cvv[3])));
                    const bool e0 = cvv[0] == m, e1 = cvv[1] == m, e2 = cvv[2] == m, e3 = cvv[3] == m;
                    const unsigned long long bal = __ballot(e0 || e1 || e2 || e3);
                    const int src = __ffsll((long long)bal) - 1;
                    const int myidx = e0 ? cii[0] : (e1 ? cii[1] : (e2 ? cii[2] : cii[3]));
                    const int idx = __shfl(myidx, src);
                    if (lane == src) { if (e0) cvv[0] = NEG; else if (e1) cvv[1] = NEG; else if (e2) cvv[2] = NEG; else cvv[3] = NEG; }
                    tv[k] = m;
                    if (lane == 0) idxs[rr * 16 + k] = idx;
                }
                float sum = 0.f;
                const float tv0 = tv[0]; _Pragma("unroll") for (int k = 0; k < 16; ++k) { tv[k] = __builtin_amdgcn_exp2f((tv[k] - tv0) * LOG2E); sum += tv[k]; }
                if (lane == 0) { _Pragma("unroll") for (int k = 0; k < 16; ++k) gts[rr * 16 + k] = tv[k] / sum; }
                LDS_WAIT();
#if defined(PEER_DBG_CMP)
                if (lane < 16) { if (idxs_f[rr * 16 + lane] != idxs[rr * 16 + lane]) ++mm2; if (fabsf(gts_f[rr * 16 + lane] - gts[rr * 16 + lane]) > 2e-3f) ++mmg; }
#endif
            }
        }
#endif
#if defined(PEER_DBG_CMP)
        { const int s1_ = (int)wave_sum((float)mm1), s2_ = (int)wave_sum((float)mm2), sg_ = (int)wave_sum((float)mmg);
          const int s3_ = (int)wave_sum((float)mm3); if (lane == 0) atomicAdd((unsigned*)(ws + WS_CTL) + 67, (unsigned)s3_);
          if (lane == 0) { atomicAdd((unsigned*)(ws + WS_CTL) + 64, (unsigned)s1_); atomicAdd((unsigned*)(ws + WS_CTL) + 65, (unsigned)s2_); atomicAdd((unsigned*)(ws + WS_CTL) + 66, (unsigned)sg_); } }
#endif
#if defined(PEER_SLOW_GATHER)
        _Pragma("unroll 1") for (int tl = 0; tl < 4; ++tl) {
            const int t = t0 + tl; float xs[32], os[32]; int lq = lane; asm volatile("" : "+v"(lq));
            _Pragma("unroll") for (int j = 0; j < 32; ++j) { xs[j] = bf1(X2[(size_t)t * DM + lq + 64 * j]); os[j] = 0.f; }
            _Pragma("unroll 1") for (int hk = 0; hk < 128; ++hk) {
                const int e = idxs[tl * 128 + hk]; const float gt = gts[tl * 128 + hk];
                int lp = lane; asm volatile("" : "+v"(lp)); const float* ur = a.in[16] + (size_t)e * DM + lp; const float* vr = a.in[17] + (size_t)e * DM + lp;
                float hv = 0.f;
                _Pragma("unroll") for (int j = 0; j < 32; ++j) hv += ur[64 * j] * xs[j];
                hv = wave_sum(hv);
                const float av = gt * 0.5f * hv * (1.f + erff(hv * 0.7071067811865476f));
                _Pragma("unroll") for (int j = 0; j < 32; ++j) os[j] += av * vr[64 * j];
            }
            float sm = 0.f;
            _Pragma("unroll") for (int j = 0; j < 32; ++j) { os[j] += ALPHA * xs[j]; sm += os[j]; }
            const float mean = wave_sum(sm) * (1.f / DM); float s2 = 0.f;
            _Pragma("unroll") for (int j = 0; j < 32; ++j) { os[j] -= mean; s2 += os[j] * os[j]; }
            const float rstd = 1.f / sqrtf(wave_sum(s2) * (1.f / DM) + LN_EPS); int lr = lane; asm volatile("" : "+v"(lr));
            _Pragma("unroll") for (int j = 0; j < 32; ++j) a.out[(size_t)t * DM + lr + 64 * j] = os[j] * rstd * a.in[18][lr + 64 * j] + a.in[19][lr + 64 * j];
        }
        if (false)
#endif
        if (PEER_PARTS & 4) {
            const int lane = fresh_lane();
            struct RowB { u32x4 q; unsigned short sc; };
            RowB w0, w1, w2, w3, w4, w5, w6, w7, w8, w9, w10, w11, w12, w13, w14, w15;
            f32x2 o2[4][4], x2[4][4];
            int lane_g = lane; asm volatile("" : "+v"(lane_g));
            const unsigned lq16 = (unsigned)lane_g * 16u, lq2 = (unsigned)lane_g * 2u;
            LAS float* hpl = tops;
            LAS float* akl = (LAS float*)(lds + wave * PEER_WLDS + 8192);
#define PEER_LOADW(W, tab, e) do { const unsigned char* r0_ = (tab) + (unsigned)__builtin_amdgcn_readfirstlane(e) * (unsigned)EROW;        \
                W.q = *(const u32x4*)(r0_ + lq16); W.sc = *(const unsigned short*)(r0_ + 1024 + lq2); } while (0)
#define PEER_DEC8(w_) const f32x2 e0 = __builtin_amdgcn_cvt_scalef32_pk_f32_fp4(w_, 1.0f, 0), e1 = __builtin_amdgcn_cvt_scalef32_pk_f32_fp4(w_, 1.0f, 1), \
                                 e2 = __builtin_amdgcn_cvt_scalef32_pk_f32_fp4(w_, 1.0f, 2), e3 = __builtin_amdgcn_cvt_scalef32_pk_f32_fp4(w_, 1.0f, 3)
#define PEER_DOTU(W, k) do { f32x2 s0 = {0.f, 0.f}, s1 = {0.f, 0.f}; \
                _Pragma("unroll") for (int d_ = 0; d_ < 4; ++d_) { PEER_DEC8(W.q[d_]); \
                    s0 += e0 * x2[d_][0]; s1 += e1 * x2[d_][1]; s0 += e2 * x2[d_][2]; s1 += e3 * x2[d_][3]; } \
                s0 += s1; hpl[(k) * 64 + lane_g] = bitsf((unsigned)W.sc << 16) * (s0.x + s0.y); } while (0)
#define PEER_FMAV(W, k) do { const float av_ = bitsf((unsigned)__builtin_amdgcn_readlane((int)fbits(avv), 4 * (k))) * bitsf((unsigned)W.sc << 16); const f32x2 av = {av_, av_}; \
                _Pragma("unroll") for (int d_ = 0; d_ < 4; ++d_) { PEER_DEC8(W.q[d_]); \
                    o2[d_][0] += av * e0; o2[d_][1] += av * e1; o2[d_][2] += av * e2; o2[d_][3] += av * e3; } } while (0)
#define SB0() __builtin_amdgcn_sched_barrier(0)
            PEER_LOADW(w0, UT, idxs[0]); PEER_LOADW(w1, UT, idxs[1]); PEER_LOADW(w2, UT, idxs[2]); PEER_LOADW(w3, UT, idxs[3]);
            PEER_LOADW(w4, UT, idxs[4]); PEER_LOADW(w5, UT, idxs[5]); PEER_LOADW(w6, UT, idxs[6]); PEER_LOADW(w7, UT, idxs[7]);
            PEER_LOADW(w8, UT, idxs[8]); PEER_LOADW(w9, UT, idxs[9]); PEER_LOADW(w10, UT, idxs[10]); PEER_LOADW(w11, UT, idxs[11]);
            PEER_LOADW(w12, UT, idxs[12]); PEER_LOADW(w13, UT, idxs[13]); PEER_LOADW(w14, UT, idxs[14]);
            int iv_cur = idxs[lane_g & 15]; float avv = 0.f;
#pragma unroll 1
            for (int g = 0; g < 32; ++g) {
                const int tl = g >> 3, h = g & 7, t = t0 + tl;
                const LAS int* ipn = idxs + (g < 31 ? g + 1 : g) * 16;
                const int iv_nxt = ipn[lane_g & 15];
                if (h == 0) {
                    int lo_ = lane; asm volatile("" : "+v"(lo_));
                    const u32x2* xr = (const u32x2*)(X2 + (size_t)t * DM) + lo_;
#pragma unroll
                    for (int c = 0; c < 4; ++c) { const u32x2 p = xr[64 * (2 * c)], q = xr[64 * (2 * c + 1)];
                        x2[c][0] = (f32x2){bflo(p.x), bflo(q.x)}; x2[c][1] = (f32x2){bfhi(p.x), bfhi(q.x)}; x2[c][2] = (f32x2){bflo(p.y), bflo(q.y)}; x2[c][3] = (f32x2){bfhi(p.y), bfhi(q.y)}; }
                    { const f32x2 mr_ = ((const f32x2*)(ws + WS_MR))[t]; const float mean_ = mr_.x, rstd_ = mr_.y;
                      const LAS f32x4* gp_ = gb + lo_; const LAS f32x4* bp_ = gb + 512 + lo_;
                      _Pragma("unroll") for (int c = 0; c < 4; ++c) { const f32x4 g0 = gp_[128 * c], g1 = gp_[128 * c + 64], b0 = bp_[128 * c], b1 = bp_[128 * c + 64];
                          x2[c][0] = (f32x2){(x2[c][0].x - mean_) * rstd_ * g0.x + b0.x, (x2[c][0].y - mean_) * rstd_ * g1.x + b1.x};
                          x2[c][1] = (f32x2){(x2[c][1].x - mean_) * rstd_ * g0.y + b0.y, (x2[c][1].y - mean_) * rstd_ * g1.y + b1.y};
                          x2[c][2] = (f32x2){(x2[c][2].x - mean_) * rstd_ * g0.z + b0.z, (x2[c][2].y - mean_) * rstd_ * g1.z + b1.z};
                          x2[c][3] = (f32x2){(x2[c][3].x - mean_) * rstd_ * g0.w + b0.w, (x2[c][3].y - mean_) * rstd_ * g1.w + b1.w}; } }
#pragma unroll
                    for (int c = 0; c < 4; ++c)
#pragma unroll
                        for (int j = 0; j < 4; ++j) o2[c][j] = (f32x2){0.f, 0.f};
                }
#define PEER_PF(W, pr) do { const int pr_ = (pr); const unsigned char* tb_ = (pr_ & 16) ? VT : UT; PEER_LOADW(W, tb_, __builtin_amdgcn_readlane(pr_ >= 32 ? iv_nxt : iv_cur, pr_ & 15)); } while (0)
                {
                    PEER_PF(w15, 15); PEER_DOTU(w0, 0); SB0();
                    PEER_PF(w0, 16); PEER_DOTU(w1, 1); SB0();
                    PEER_PF(w1, 17); PEER_DOTU(w2, 2); SB0();
                    PEER_PF(w2, 18); PEER_DOTU(w3, 3); SB0();
                    PEER_PF(w3, 19); PEER_DOTU(w4, 4); SB0();
                    PEER_PF(w4, 20); PEER_DOTU(w5, 5); SB0();
                    PEER_PF(w5, 21); PEER_DOTU(w6, 6); SB0();
                    PEER_PF(w6, 22); PEER_DOTU(w7, 7); SB0();
                    PEER_PF(w7, 23); PEER_DOTU(w8, 8); SB0();
                    PEER_PF(w8, 24); PEER_DOTU(w9, 9); SB0();
                    PEER_PF(w9, 25); PEER_DOTU(w10, 10); SB0();
                    PEER_PF(w10, 26); PEER_DOTU(w11, 11); SB0();
                    PEER_PF(w11, 27); PEER_DOTU(w12, 12); SB0();
                    PEER_PF(w12, 28); PEER_DOTU(w13, 13); SB0();
                    PEER_PF(w13, 29); PEER_DOTU(w14, 14); SB0();
                    PEER_PF(w14, 30); PEER_DOTU(w15, 15); SB0();
                }
                {
                    LDS_WAIT();
                    const LAS f32x4* hp4 = (const LAS f32x4*)(hpl + (lane >> 2) * 64 + (lane & 3) * 16);
                    const f32x4 p0 = hp4[0], p1 = hp4[1], p2 = hp4[2], p3 = hp4[3];
                    float hv = ((p0.x + p0.y) + (p0.z + p0.w)) + ((p1.x + p1.y) + (p1.z + p1.w)) + ((p2.x + p2.y) + (p2.z + p2.w)) + ((p3.x + p3.y) + (p3.z + p3.w));
                    hv += dpp_xor1(hv); hv += dpp_xor2(hv);
                    avv = gts[g * 16 + (lane >> 2)] * 0.5f * hv * (1.f + erf_f32(hv * 0.7071067811865476f));
                    SB0();
                }
                {
                    PEER_PF(w15, 31); PEER_FMAV(w0, 0); SB0();
                    PEER_PF(w0, 32); PEER_FMAV(w1, 1); SB0();
                    PEER_PF(w1, 33); PEER_FMAV(w2, 2); SB0();
                    PEER_PF(w2, 34); PEER_FMAV(w3, 3); SB0();
                    PEER_PF(w3, 35); PEER_FMAV(w4, 4); SB0();
                    PEER_PF(w4, 36); PEER_FMAV(w5, 5); SB0();
                    PEER_PF(w5, 37); PEER_FMAV(w6, 6); SB0();
                    PEER_PF(w6, 38); PEER_FMAV(w7, 7); SB0();
                    PEER_PF(w7, 39); PEER_FMAV(w8, 8); SB0();
                    PEER_PF(w8, 40); PEER_FMAV(w9, 9); SB0();
                    PEER_PF(w9, 41); PEER_FMAV(w10, 10); SB0();
                    PEER_PF(w10, 42); PEER_FMAV(w11, 11); SB0();
                    PEER_PF(w11, 43); PEER_FMAV(w12, 12); SB0();
                    PEER_PF(w12, 44); PEER_FMAV(w13, 13); SB0();
                    PEER_PF(w13, 45); PEER_FMAV(w14, 14); SB0();
                    PEER_PF(w14, 46); PEER_FMAV(w15, 15); SB0();
                }
                if (h == 7) {
                    f32x2 s = {0.f, 0.f};
#pragma unroll
                    for (int c = 0; c < 4; ++c) {
#pragma unroll
                        for (int j = 0; j < 4; ++j) { o2[c][j] += ALPHA * x2[c][j]; s += o2[c][j]; } }
                    const float mean = wave_sum(s.x + s.y) * (1.f / DM); f32x2 s2 = {0.f, 0.f};
#pragma unroll
                    for (int c = 0; c < 4; ++c)
#pragma unroll
                        for (int j = 0; j < 4; ++j) { o2[c][j] -= mean; s2 += o2[c][j] * o2[c][j]; }
                    const float rstd = 1.f / sqrtf(wave_sum(s2.x + s2.y) * (1.f / DM) + LN_EPS);
                    int lo_ = lane; asm volatile("" : "+v"(lo_));
                    f32x4* orow = (f32x4*)(a.out + (size_t)t * DM) + lo_;
                    const LAS f32x4* g4 = gb + 1024 + lo_; const LAS f32x4* b4p = gb + 1536 + lo_;
#pragma unroll
                    for (int c = 0; c < 4; ++c) {
                        { const int m = 2 * c; const f32x4 gg = g4[64 * m], bb = b4p[64 * m];
                          __builtin_nontemporal_store((f32x4){o2[c][0].x * rstd * gg.x + bb.x, o2[c][1].x * rstd * gg.y + bb.y, o2[c][2].x * rstd * gg.z + bb.z, o2[c][3].x * rstd * gg.w + bb.w}, &orow[64 * m]); SB0(); }
                        { const int m = 2 * c + 1; const f32x4 gg = g4[64 * m], bb = b4p[64 * m];
                          __builtin_nontemporal_store((f32x4){o2[c][0].y * rstd * gg.x + bb.x, o2[c][1].y * rstd * gg.y + bb.y, o2[c][2].y * rstd * gg.z + bb.z, o2[c][3].y * rstd * gg.w + bb.w}, &orow[64 * m]); SB0(); }
                    }
                }
                iv_cur = iv_nxt;
            }
#undef PEER_LOADW
#undef PEER_PF
#undef PEER_DEC8
#undef PEER_DOTU
#undef PEER_FMAV
#undef SB0
        }
        LDS_WAIT();
    }
}


#define XB_TMO      128
#define XB_XCNT(j)  (256  + 64 * (j))
#define XB_XSUB(j)  (1280 + 64 * (j))
#define XB_XGEN(j)  (2304 + 64 * (j))
#define XB_TOP      3328
#define XB_TOPGEN   3392
#define XB_SPIN_CAP (1u << 22)
constexpr int CW_BAR = 4096;
__device__ __forceinline__ unsigned xb_ld(unsigned* p)              { return __hip_atomic_load(p, __ATOMIC_RELAXED, __HIP_MEMORY_SCOPE_AGENT); }
__device__ __forceinline__ unsigned xb_add(unsigned* p, unsigned v) { return __hip_atomic_fetch_add(p, v, __ATOMIC_RELAXED, __HIP_MEMORY_SCOPE_AGENT); }
__device__ __forceinline__ unsigned xb_xcc_id() { return (unsigned)__builtin_amdgcn_s_getreg((3 << 11) | 20) & 0xFu; }
#define XB_SPIN(cond, bar) do { unsigned _sp = 0; while (cond) { __builtin_amdgcn_s_sleep(1); \
    if ((++_sp & 255u) == 0u) { if (xb_ld(&(bar)[XB_TMO])) break; if (_sp > XB_SPIN_CAP) { atomicAdd(&(bar)[XB_TMO], 1u); break; } } } } while (0)
struct XcdBarrier { unsigned* bar; unsigned x; volatile LAS unsigned* st; };
__device__ __forceinline__ XcdBarrier xcd_barrier_post(unsigned* bar, volatile LAS unsigned* st, bool leader) {
    XcdBarrier b; b.bar = bar; b.x = xb_xcc_id(); b.st = st;
    if (leader) (void)xb_add(&bar[XB_XCNT(b.x)], 1u);
    return b;
}
__device__ __forceinline__ void xcd_barrier_complete(unsigned* bar, unsigned x, unsigned& nloc, unsigned& nx, unsigned G) {
    unsigned sum, cnt, mine, sp = 0u;
    for (;;) {
        sum = 0u; cnt = 0u; mine = 0u;
#pragma unroll
        for (unsigned j = 0; j < 16; ++j) { const unsigned c = xb_ld(&bar[XB_XCNT(j)]); sum += c; cnt += (c > 0u) ? 1u : 0u; mine = (j == x) ? c : mine; }
        if (sum == G) break;
        __builtin_amdgcn_s_sleep(1);
        if ((++sp & 255u) == 0u) { if (xb_ld(&bar[XB_TMO])) break; if (sp > XB_SPIN_CAP) { atomicAdd(&bar[XB_TMO], 1u); break; } }
    }
    nloc = mine > 0u ? mine : 1u; nx = cnt > 0u ? cnt : 1u;
}
__device__ __forceinline__ void xcd_barrier(const XcdBarrier& b, bool leader, unsigned G) {
    asm volatile("s_waitcnt vmcnt(0)" ::: "memory");
    __syncthreads();
    if (leader) {
        unsigned* bar = b.bar;
        __builtin_amdgcn_s_waitcnt(0);
        unsigned nloc = b.st[0], nx = b.st[1];
        if (nloc == 0u) { xcd_barrier_complete(bar, b.x, nloc, nx, G); b.st[0] = nloc; b.st[1] = nx; }
        const unsigned old = xb_add(&bar[XB_XSUB(b.x)], 1u);
        const unsigned gen = old / nloc;
        if (old + 1u == (gen + 1u) * nloc) {
            __builtin_amdgcn_fence(__ATOMIC_RELEASE, "agent");
            asm volatile("s_waitcnt vmcnt(0)" ::: "memory");
            const unsigned og = xb_add(&bar[XB_TOP], 1u);
            const unsigned tg = og / nx;
            if (og + 1u == (tg + 1u) * nx) xb_add(&bar[XB_TOPGEN], 1u);
            else XB_SPIN(xb_ld(&bar[XB_TOPGEN]) == tg, bar);
            __builtin_amdgcn_fence(__ATOMIC_ACQUIRE, "agent");
            xb_add(&bar[XB_XGEN(b.x)], 1u);
            asm volatile("s_waitcnt vmcnt(0)" ::: "memory");
        } else {
            XB_SPIN(xb_ld(&bar[XB_XGEN(b.x)]) == gen, bar);
            __builtin_amdgcn_fence(__ATOMIC_ACQUIRE, "agent");
            asm volatile("s_waitcnt vmcnt(0)" ::: "memory");
        }
    }
    __syncthreads();
}
__global__ void __launch_bounds__(NTHREADS, 2) fwd_kernel(Args a) {
    extern __shared__ __attribute__((aligned(16))) unsigned char lds_raw[];
    LAS unsigned char* lds = (LAS unsigned char*)lds_raw;
    const int tid = threadIdx.x, lane = tid & 63, wave = __builtin_amdgcn_readfirstlane(tid >> 6);
    const int G = gridDim.x, blk = blockIdx.x;
    const int gw = blk * NWAVES + wave, NGW = G * NWAVES;
    unsigned char* ws = a.ws;
#ifndef PH_MASK
#define PH_MASK 0xFFFF
#endif
#ifndef REPEAT_PH
#define REPEAT_PH -1
#endif
#define IN(k) (((PH_MASK >> (k)) & 1) && a.ph_lo <= (k) && (k) < a.ph_hi)
#define REP(k) for (int rep_ = 0; rep_ < ((k) == REPEAT_PH ? 2 : 1); ++rep_)
#if N_LAUNCH_MODE == 1
    cg::grid_group grid = cg::this_grid();
    volatile LAS unsigned* bst = (volatile LAS unsigned*)(lds + LDS_BYTES - 64);
    if (tid < 2) bst[tid] = 0u;
    __syncthreads();
    const XcdBarrier xbar = xcd_barrier_post((unsigned*)(ws + WS_CTL) + CW_BAR, bst, tid == 0);
#define SEAM(k) do { if (IN(k) && IN((k) + 1)) { if ((k) == 0 && a.ph_hi > 64) grid.sync(); else xcd_barrier(xbar, tid == 0, (unsigned)G); } } while (0)
#else
#define SEAM(k) do { } while (0)
#endif
    if (IN(0)) REP(0) { p0_prologue(a, lds, gw, NGW, wave, lane); }
    SEAM(0);
    if (IN(1)) REP(1) {
        pg8::Gemm g{DM, DM, DM};
        SchedP1 S{(const char*)(ws + WS_XB), (const char*)(ws + WS_WIN), (const char*)(ws + WS_MEMB), (const char*)(ws + WS_WMKV), G, blk, 0, 768};
        EpiP1 E{(bf16_t*)(ws + WS_PROJ), (bf16_t*)(ws + WS_KM), (bf16_t*)(ws + WS_VMT), (const f32x2*)(ws + WS_ROPE)};
        pg8::gemm_phase(lds, g, S, E);
    }
    SEAM(1);
#if ATTN_FAST && N_LAUNCH_MODE == 1
    if (IN(2)) REP(2) { attn_fast_phase(a, lds, (bf16_t*)(ws + WS_MIX), blk, G); p0_late(a, lds, gw, NGW, wave, lane); }
#elif ATTN_FAST
#else
    if (IN(2)) REP(2) { attn_naive_phase(a, lds, gw, NGW, wave, lane); }
#endif
    SEAM(2);
    if (IN(3)) REP(3) {
        pg8::Gemm g{DM, DM, DM};
        SchedSimple S{(const char*)(ws + WS_MIX), (const char*)(ws + WS_WO), 32, 8, G, blk, (size_t)256 * DM * 2, (size_t)256 * DM * 2};
        EpiRes<true> E{(const void*)(ws + WS_XB), (bf16_t*)(ws + WS_Y)};
        pg8::gemm_phase(lds, g, S, E);
    }
    SEAM(3);
    if (IN(4)) REP(4) {
        if (blk < 64) {
            pg8::Gemm g{512, DM, DM};
            SchedMKV S{(const char*)(ws + WS_MEMB), (const char*)(ws + WS_WMKV), blk};
            EpiMKV E{(float*)(ws + WS_PART)};
            pg8::gemm_phase(lds, g, S, E);
        } else { ln_phase((const bf16_t*)(ws + WS_Y), (bf16_t*)(ws + WS_X1), a.in[7], a.in[8], gw - 64 * NWAVES, NGW - 64 * NWAVES, lane);
            LAS float* scr = (LAS float*)(lds + wave * 16384);
            for (int item = gw - 64 * NWAVES; item < 32 * (DM / 32); item += NGW - 64 * NWAVES) pq_transpose_item(a.in[14], a.in[12], a.in[13], (bf16_t*)(ws + WS_WPQ), (float*)(ws + WS_P1), (float*)(ws + WS_P2), scr, item, lane);
            for (int r = 2 * NEXP - NE_P4 + gw - 64 * NWAVES; r < 2 * NEXP; r += NGW - 64 * NWAVES) cvt_expert_idx(a, r, lane); }
    }
    SEAM(4);
    if (IN(5)) REP(5) { mkv_reduce((const float*)(ws + WS_PART), (bf16_t*)(ws + WS_KM), (bf16_t*)(ws + WS_VMT), blk * NTHREADS + tid, G * NTHREADS);
        { const int n = blk * NTHREADS + tid; if (n < DM) { const float* P1 = (const float*)(ws + WS_P1); const float* P2 = (const float*)(ws + WS_P2); float c1 = 0.f, c2 = 0.f;
            for (int kb = 0; kb < 32; ++kb) { c1 += P1[(size_t)kb * DM + n]; c2 += P2[(size_t)kb * DM + n]; }
            ((f32x2*)(ws + WS_C12))[n] = (f32x2){c1, c2}; } } }
    SEAM(5);
    if (IN(6)) REP(6) {
        if (blk < 32) {
            pg8::Gemm g{512, DM, DM};
            SchedMT S{(const char*)(ws + WS_KM), (const char*)(ws + WS_WMQ), blk};
            EpiBf16 E{(bf16_t*)(ws + WS_MT), DM, C_XA};
            pg8::gemm_phase(lds, g, S, E);
        } else if (blk < 64) {
            pg8::Gemm g{512, DM, DM};
            SchedVW S{(const char*)(ws + WS_WMO), (const char*)(ws + WS_VMT), blk - 32};
            EpiBf16 E{(bf16_t*)(ws + WS_VWT), 1024, 1.f};
            pg8::gemm_phase(lds, g, S, E);
        } else {
            for (int r = NE_P0 + gw - 64 * NWAVES; r < NE_P0 + NE_T6; r += NGW - 64 * NWAVES) cvt_expert_idx(a, r, lane);
        }
    }
    SEAM(6);
    if (IN(6) && IN(7)) {
        pg8::Gemm g{DM, DM, DM};
        SchedSimple S{(const char*)(ws + WS_X1), (const char*)(ws + WS_MT), 32, 4, G, blk, (size_t)256 * DM * 2, (size_t)256 * DM * 2};
        EpiSoftmaxP E{(bf16_t*)(ws + WS_OM), lds};
        pg8::gemm_phase(lds, g, S, E);
        if (blk >= 128) { for (int r = NE_P0 + NE_T6 + gw - 128 * NWAVES; r < 2 * NEXP - NE_P4; r += NGW - 128 * NWAVES) cvt_expert_idx(a, r, lane); }
        xcd_barrier(xbar, tid == 0, (unsigned)G);
    }
    if (IN(7)) REP(7) {
        pg8::Gemm g{1024, 1024, 1024};
        SchedSimple S{(const char*)(ws + WS_OM), (const char*)(ws + WS_VWT), 32, 8, G, blk, (size_t)256 * 1024 * 2, (size_t)256 * 1024 * 2};
        EpiResStats E{(const bf16_t*)(ws + WS_X1), (bf16_t*)(ws + WS_Y), (f32x2*)(ws + WS_PS)};
        pg8::gemm_phase(lds, g, S, E);
    }
    SEAM(7);
    if (IN(9)) REP(9) {
        pg8::Gemm g{DM, DM, DM};
        SchedSimple S{(const char*)(ws + WS_Y), (const char*)(ws + WS_WPQ), 32, 8, G, blk, (size_t)256 * DM * 2, (size_t)256 * DM * 2};
        EpiPQ E{(bf16_t*)(ws + WS_QP), (const f32x2*)(ws + WS_PS), (const f32x2*)(ws + WS_C12), (f32x2*)(ws + WS_MR)};
        pg8::gemm_phase(lds, g, S, E);
    }
    SEAM(9);
    if (IN(10)) REP(10) { peer_phase(a, lds, blk, G, wave, lane); }
#if defined(PEER_DBG_CMP)
    if (a.ph_lo == 11) { const unsigned cnt = ((const unsigned*)(ws + WS_CTL))[64 + PEER_DBG_CMP - 1]; const float frac = (float)cnt / (PEER_DBG_CMP == 1 ? 8192.f * 8 * 32 : (PEER_DBG_CMP == 4 ? 8192.f * 8 * 256 : 8192.f * 128));
        const float cval = 10.f * frac; for (size_t i = (size_t)blk * NTHREADS + tid; i < (size_t)SEQ * DM; i += (size_t)G * NTHREADS) a.out[i] = cval; }
#endif
#undef IN
#undef SEAM
}

#if ATTN_FAST && N_LAUNCH_MODE == 0
__global__ void __launch_bounds__(NTHREADS, 2) attn_kernel(Args a) {
    extern __shared__ __attribute__((aligned(16))) unsigned char lds_raw[];
    attn_fast_phase(a, (LAS unsigned char*)lds_raw, (bf16_t*)(a.ws + WS_MIX), blockIdx.x, gridDim.x);
}
#endif
#if defined(PEER_DBG_CMP)
constexpr int N_PHASES = 12;
#else
constexpr int N_PHASES = 11;
#endif
extern "C" void kernel_launch(void* const* d_in, const int* in_sizes, int n_in, void* d_out, int out_size, void* d_ws, size_t ws_size, hipStream_t stream) {
    static int grid = 0;
    if (grid == 0) {
        if (n_in != 20 || in_sizes[0] != SEQ * DM || out_size != SEQ * DM || ws_size < WS_END) {
            fprintf(stderr, "kernel_launch: unexpected shapes: n_in %d in0 %d out %d ws %zu (need %zu)\n", n_in, n_in > 0 ? in_sizes[0] : -1, out_size, ws_size, (size_t)WS_END);
            grid = -1; return; }
        int dev = 0, cus = 0, per_cu = 0;
        (void)hipGetDevice(&dev); (void)hipDeviceGetAttribute(&cus, hipDeviceAttributeMultiprocessorCount, dev);
#if ATTN_FAST && N_LAUNCH_MODE == 0
        (void)hipFuncSetAttribute((const void*)attn_kernel, hipFuncAttributeMaxDynamicSharedMemorySize, LDS_BYTES);
#endif
        if (hipFuncSetAttribute((const void*)fwd_kernel, hipFuncAttributeMaxDynamicSharedMemorySize, LDS_BYTES) != hipSuccess) { fprintf(stderr, "kernel_launch: hipFuncSetAttribute failed\n"); grid = -1; return; }
        if (hipOccupancyMaxActiveBlocksPerMultiprocessor(&per_cu, (const void*)fwd_kernel, NTHREADS, LDS_BYTES) != hipSuccess || per_cu < 1) { fprintf(stderr, "kernel_launch: occupancy query says %d\n", per_cu); per_cu = 1; }
        (void)hipGetLastError();
        if (cus <= 0) cus = 256;
        grid = cus;
    }
    if (grid < 0) return;
    (void)hipMemsetAsync((char*)d_ws + WS_CTL, 0, 64 * 1024, stream);
    Args a{};
    for (int i = 0; i < 20; ++i) a.in[i] = (const float*)d_in[i];
    a.out = (float*)d_out; a.ws = (unsigned char*)d_ws;
#if N_LAUNCH_MODE == 1
    a.ph_lo = 0; a.ph_hi = N_PHASES;
    void* args[] = {&a};
    hipError_t e = hipLaunchCooperativeKernel((const void*)fwd_kernel, dim3(grid), dim3(NTHREADS), args, LDS_BYTES, stream);
    if (e != hipSuccess) fprintf(stderr, "kernel_launch: cooperative launch failed: %s\n", hipGetErrorString(e));
#else
    for (int p = 0; p < N_PHASES; ++p) {
        a.ph_lo = p; a.ph_hi = p + 1;
#if ATTN_FAST
        if (p == 2) { hipLaunchKernelGGL(attn_kernel, dim3(grid), dim3(NTHREADS), LDS_BYTES, stream, a); continue; }
#endif
        hipLaunchKernelGGL(fwd_kernel, dim3(grid), dim3(NTHREADS), LDS_BYTES, stream, a);
    }
    const hipError_t le = hipPeekAtLastError();
    if (le != hipSuccess) fprintf(stderr, "kernel_launch: launch failed: %s\n", hipGetErrorName(le));
#endif
}
```
